# Optimizing an MI355X kernel written in HIP

```python
import math
import jax
import jax.numpy as jnp
from jax import lax
import numpy as np

D_MODEL = 1024
BATCH = 8
SEQ = 4096
DEPTH = 4

GRID_W = 64
CTX_LEN = 256

ATT_HEADS = 4
ATT_QK = 64
ATT_V = 2 * ATT_QK
ATT_WIDTH = ATT_HEADS * ATT_V
AXIS_DIM = ATT_QK // 2
ROPE_THETA = 10000.0
Q_BLOCK = 128
SUBLN_EPS = 1e-5

RWKV_HEADS = 4
RWKV_N = 64
RWKV_WIDTH = RWKV_HEADS * RWKV_N
DECAY_LORA = 32
ICLR_LORA = 32
GATE_LORA = 64
N_DIR = 2
GN_EPS = 64e-5

CONV_WIDTH = 256
CONV_K = 3

MIX_WIDTH = ATT_WIDTH + RWKV_WIDTH + CONV_WIDTH
IN_SIZES = (ATT_WIDTH, ATT_WIDTH, ATT_WIDTH,
            RWKV_WIDTH, RWKV_WIDTH, RWKV_WIDTH, N_DIR * DECAY_LORA, N_DIR * ICLR_LORA, GATE_LORA,
            CONV_WIDTH, CONV_WIDTH, CONV_WIDTH)
IN_WIDTH = sum(IN_SIZES)
IN_OFFSETS = tuple(int(o) for o in np.cumsum(IN_SIZES)[:-1])

D_FF = 2816
N_EXPERTS = 8
TOP_K = 2
D_FF_EXPERT = 1408
N_DENSE = (DEPTH + 1) // 2
N_MOE = DEPTH // 2

DN_ALPHA = (2 * DEPTH) ** 0.25
DN_BETA = (8 * DEPTH) ** -0.25
LN_EPS = 1e-5

kernel_name = 'hybrid_diffattn_rwkv7_shortconv_moe_dit'


def layer_norm(x, g, b, eps=LN_EPS):
    xf = x.astype(jnp.float32)
    mu = xf.mean(-1, keepdims=True)
    var = jnp.square(xf - mu).mean(-1, keepdims=True)
    return ((xf - mu) * lax.rsqrt(var + eps) * g + b).astype(x.dtype)


def rms_norm(x, g, eps):
    xf = x.astype(jnp.float32)
    return (xf * lax.rsqrt(jnp.mean(xf * xf, -1, keepdims=True) + eps) * g).astype(x.dtype)


def head_norm(y, g, b, eps):
    yf = y.astype(jnp.float32)
    mu = yf.mean(-1, keepdims=True)
    var = jnp.square(yf - mu).mean(-1, keepdims=True)
    yn = (yf - mu) * lax.rsqrt(var + eps)
    return yn.reshape(y.shape[:-2] + (-1,)) * g + b


def short_conv(u, w):
    return lax.conv_general_dilated(
        u, w[:, None, :].astype(u.dtype), window_strides=(1,),
        padding=((CONV_K // 2, CONV_K // 2),), dimension_numbers=('NWC', 'WIO', 'NWC'),
        feature_group_count=u.shape[-1])


def axial_rope(x, row, col):
    b, t, h, m, _ = x.shape
    inv = ROPE_THETA ** (-jnp.arange(0, AXIS_DIM, 2, dtype=jnp.float32) / AXIS_DIM)
    ang = jnp.stack([row, col], -1).astype(jnp.float32)[..., None] * inv
    cos = jnp.cos(ang)[None, :, None, None]
    sin = jnp.sin(ang)[None, :, None, None]
    xf = x.astype(jnp.float32).reshape(b, t, h, m, 2, 2, AXIS_DIM // 2)
    x1, x2 = xf[..., 0, :], xf[..., 1, :]
    out = jnp.stack([x1 * cos - x2 * sin, x2 * cos + x1 * sin], -2)
    return out.reshape(x.shape).astype(x.dtype)


def diff_attend(q, k, v, lam):
    s = jnp.einsum('bqhmd,bkhmd->bhmqk', q, k).astype(jnp.float32) * (ATT_QK ** -0.5)
    p = jax.nn.softmax(s, axis=-1)
    w = p[:, :, 0] - lam * p[:, :, 1]
    return jnp.einsum('bhqk,bkhd->bqhd', w.astype(v.dtype), v)


def blockwise_diff_attend(q, k, v, lam):
    b, t = q.shape[:2]
    nb = t // Q_BLOCK
    qb = jnp.moveaxis(q.reshape((b, nb, Q_BLOCK) + q.shape[2:]), 1, 0)
    ob = lax.map(lambda qi: diff_attend(qi, k, v, lam), qb)
    return jnp.moveaxis(ob, 0, 1).reshape(b, t, ATT_HEADS, ATT_V)


def rwkv_prepare(r, k, v, wd, ad, gd, conv_w, w0, w_up, a0, a_up, g_up, k_k, k_a):
    r, k, v = jnp.split(short_conv(jnp.concatenate([r, k, v], -1), conv_w), 3, axis=-1)
    b, t, _ = r.shape
    wl = w0[:, None, None, :] + jnp.einsum('btdr,drc->dbtc', jnp.tanh(wd.reshape(b, t, N_DIR, DECAY_LORA)), w_up)
    decay = jnp.exp(-jnp.exp(-jax.nn.softplus(-wl.astype(jnp.float32)) - 0.5))
    a = jax.nn.sigmoid(a0[:, None, None, :] + jnp.einsum('btdr,drc->dbtc', ad.reshape(b, t, N_DIR, ICLR_LORA), a_up))
    g = jax.nn.sigmoid(gd) @ g_up
    kk = (k * k_k).reshape(b, t, RWKV_HEADS, RWKV_N).astype(jnp.float32)
    kk = (kk * lax.rsqrt(jnp.maximum(jnp.sum(kk * kk, -1, keepdims=True), 1e-24))).reshape(b, t, RWKV_WIDTH)
    kd = k * (1.0 + (a - 1.0) * k_a)
    return r, v, kk, decay, a, kd, g


def rwkv_scan(state0, r, v, kk, decay, a, kd, emit):
    def to_scan(u):
        u = jnp.stack([u[0], jnp.flip(u[1], 1)]).astype(jnp.float32)
        d, b, t, _ = u.shape
        return jnp.transpose(u, (2, 0, 1, 3)).reshape(t, d, b, RWKV_HEADS, RWKV_N)

    def both(u):
        return jnp.stack([u, u])

    xs = (to_scan(decay), to_scan(kd), to_scan(both(v)), to_scan(both(kk)), to_scan(a))
    if emit:
        xs = xs + (to_scan(both(r)),)

    def step(s, inp):
        w_t, k_t, v_t, kk_t, a_t = inp[:5]
        sa = jnp.einsum('dbhvk,dbhk->dbhv', s, -kk_t)
        s = s * w_t[..., None, :] + sa[..., None] * (kk_t * a_t)[..., None, :] + v_t[..., None] * k_t[..., None, :]
        y = jnp.einsum('dbhvk,dbhk->dbhv', s, inp[5]) if emit else None
        return s, y

    s, y = lax.scan(step, state0, xs)
    if not emit:
        return s, None
    y = y[:, 0] + jnp.flip(y[:, 1], 0)
    return s, jnp.transpose(y, (1, 0, 2, 3))


def rwkv_output(y, r, kd, v, g, r_k, gn_g, gn_b):
    b, t, _ = r.shape
    hs = lambda u: u.reshape(u.shape[:-1] + (RWKV_HEADS, RWKV_N))
    yn = head_norm(y, gn_g, gn_b, GN_EPS)
    bonus = jnp.sum(hs(r) * hs(kd) * r_k, axis=(0, -1)).astype(jnp.float32)
    out = yn + (bonus[..., None] * hs(v)).reshape(b, t, RWKV_WIDTH)
    return (out * g).astype(r.dtype)


def token_mixer(hl, hc, row, col, lam, lam_init, with_ctx, w_in, subln_g, rkv_conv, decay_w0, decay_up,
                iclr_a0, iclr_up, gate_up, k_k, k_a, r_k, gn_g, gn_b, conv_w, w_out):
    (q_l, k_l, v_l, rr_l, rk_l, rv_l, wd_l, ad_l, gd_l, ch_l, cb_l, cc_l) = jnp.split(hl @ w_in, IN_OFFSETS, axis=-1)
    (q_c, k_c, v_c, rr_c, rk_c, rv_c, wd_c, ad_c, gd_c, ch_c, cb_c, cc_c) = jnp.split(hc @ w_in, IN_OFFSETS, axis=-1)
    qk_heads = lambda u: u.reshape(u.shape[:2] + (ATT_HEADS, 2, ATT_QK))
    v_heads = lambda u: u.reshape(u.shape[:2] + (ATT_HEADS, ATT_V))
    att_post = lambda o: (rms_norm(o, subln_g, SUBLN_EPS) * (1.0 - lam_init)).reshape(o.shape[:2] + (ATT_WIDTH,))

    kc, vc = qk_heads(k_c), v_heads(v_c)
    k_all = jnp.concatenate([kc, axial_rope(qk_heads(k_l), row, col)], axis=1)
    v_all = jnp.concatenate([vc, v_heads(v_l)], axis=1)
    att_l = att_post(blockwise_diff_attend(axial_rope(qk_heads(q_l), row, col), k_all, v_all, lam))

    rw_args = (rkv_conv, decay_w0, decay_up, iclr_a0, iclr_up, gate_up, k_k, k_a)
    r_c, vr_c, kk_c, dec_c, a_c, kd_c, g_c = rwkv_prepare(rr_c, rk_c, rv_c, wd_c, ad_c, gd_c, *rw_args)
    r_l, vr_l, kk_l, dec_l, a_l, kd_l, g_l = rwkv_prepare(rr_l, rk_l, rv_l, wd_l, ad_l, gd_l, *rw_args)
    state0 = jnp.zeros((N_DIR, hl.shape[0], RWKV_HEADS, RWKV_N, RWKV_N), jnp.float32)
    s_ctx, y_c = rwkv_scan(state0, r_c, vr_c, kk_c, dec_c, a_c, kd_c, with_ctx)
    _, y_l = rwkv_scan(s_ctx, r_l, vr_l, kk_l, dec_l, a_l, kd_l, True)
    rwkv_l = rwkv_output(y_l, r_l, kd_l, vr_l, g_l, r_k, gn_g, gn_b)

    conv_l = cb_l * short_conv(cc_l * ch_l, conv_w)

    out_l = jnp.concatenate([att_l, rwkv_l, conv_l], axis=-1) @ w_out
    if not with_ctx:
        return out_l, None
    att_c = att_post(diff_attend(qk_heads(q_c), kc, vc, lam))
    rwkv_c = rwkv_output(y_c, r_c, kd_c, vr_c, g_c, r_k, gn_g, gn_b)
    conv_c = cb_c * short_conv(cc_c * ch_c, conv_w)
    out_c = jnp.concatenate([att_c, rwkv_c, conv_c], axis=-1) @ w_out
    return out_l, out_c


def swiglu(h, w1, w3, w2):
    return (jax.nn.silu(h @ w1) * (h @ w3)) @ w2


def moe_swiglu(h, router_w, router_b, w1, w3, w2):
    logits = (h @ router_w).astype(jnp.float32) + router_b
    top_logit, top_idx = lax.top_k(logits, TOP_K)
    top_gate = jax.nn.softmax(top_logit, axis=-1)
    gates = jnp.sum(jax.nn.one_hot(top_idx, N_EXPERTS, dtype=jnp.float32) * top_gate[..., None], axis=-2)
    out = jnp.zeros_like(h)
    for e in range(N_EXPERTS):
        out = out + gates[..., e:e + 1].astype(h.dtype) * swiglu(h, w1[e], w3[e], w2[e])
    return out


def setup_inputs(seed: int = 0) -> dict:
    key = jax.random.key(seed)
    keys = iter(jax.random.split(key, 48))

    def nrm(shape, scale):
        return jax.random.normal(next(keys), shape, jnp.float32) * scale

    L, D = DEPTH, D_MODEL
    centre_tap = jnp.array([0.0, 1.0, 0.0], jnp.float32)[None, :, None]
    return {
        'x': nrm((BATCH, SEQ, D), 1.0),
        'c': nrm((BATCH, D), 1.0),
        'ctx': nrm((BATCH, CTX_LEN, D), 1.0),
        'c_ctx': nrm((D,), 1.0),
        'w_ada': nrm((L, D, 6 * D), 0.5 * D ** -0.5),
        'b_ada': nrm((L, 6 * D), 0.02),
        'w_in': nrm((L, D, IN_WIDTH), D ** -0.5),
        'w_out': nrm((L, MIX_WIDTH, D), DN_BETA * MIX_WIDTH ** -0.5),
        'ln1_g': 1.0 + nrm((L, D), 0.02),
        'ln1_b': nrm((L, D), 0.02),
        'ln2_g': 1.0 + nrm((L, D), 0.02),
        'ln2_b': nrm((L, D), 0.02),
        'lam_q1': nrm((L, ATT_QK), 0.1),
        'lam_k1': nrm((L, ATT_QK), 0.1),
        'lam_q2': nrm((L, ATT_QK), 0.1),
        'lam_k2': nrm((L, ATT_QK), 0.1),
        'subln_g': 1.0 + nrm((L, ATT_V), 0.02),
        'rkv_conv': nrm((L, CONV_K, 3 * RWKV_WIDTH), 0.2) + centre_tap,
        'decay_w0': nrm((L, N_DIR, RWKV_WIDTH), 1.0) - 2.0,
        'decay_up': nrm((L, N_DIR, DECAY_LORA, RWKV_WIDTH), 0.1),
        'iclr_a0': nrm((L, N_DIR, RWKV_WIDTH), 0.5),
        'iclr_up': nrm((L, N_DIR, ICLR_LORA, RWKV_WIDTH), 0.1),
        'gate_up': nrm((L, GATE_LORA, RWKV_WIDTH), GATE_LORA ** -0.5),
        'k_k': 0.85 + nrm((L, RWKV_WIDTH), 0.05),
        'k_a': 1.0 + nrm((L, RWKV_WIDTH), 0.05),
        'r_k': nrm((L, RWKV_HEADS, RWKV_N), 0.1),
        'gn_g': 1.0 + nrm((L, RWKV_WIDTH), 0.02),
        'gn_b': nrm((L, RWKV_WIDTH), 0.02),
        'conv_w': nrm((L, CONV_K, CONV_WIDTH), CONV_K ** -0.5),
        'ffn_w1': nrm((N_DENSE, D, D_FF), D ** -0.5),
        'ffn_w3': nrm((N_DENSE, D, D_FF), D ** -0.5),
        'ffn_w2': nrm((N_DENSE, D_FF, D), DN_BETA * D_FF ** -0.5),
        'router_w': nrm((N_MOE, D, N_EXPERTS), D ** -0.5),
        'router_b': nrm((N_MOE, N_EXPERTS), 0.01),
        'moe_w1': nrm((N_MOE, N_EXPERTS, D, D_FF_EXPERT), D ** -0.5),
        'moe_w3': nrm((N_MOE, N_EXPERTS, D, D_FF_EXPERT), D ** -0.5),
        'moe_w2': nrm((N_MOE, N_EXPERTS, D_FF_EXPERT, D), DN_BETA * D_FF_EXPERT ** -0.5),
    }


def reference(x, c, ctx, c_ctx, w_ada, b_ada, w_in, w_out, ln1_g, ln1_b, ln2_g, ln2_b,
              lam_q1, lam_k1, lam_q2, lam_k2, subln_g, rkv_conv, decay_w0, decay_up, iclr_a0, iclr_up,
              gate_up, k_k, k_a, r_k, gn_g, gn_b, conv_w, ffn_w1, ffn_w3, ffn_w2,
              router_w, router_b, moe_w1, moe_w3, moe_w2):
    t = x.shape[1]
    rows = t // GRID_W
    row = jnp.repeat(jnp.arange(rows), GRID_W)
    col = jnp.tile(jnp.arange(GRID_W), rows)
    xl, xc = x, ctx
    sc, scc = jax.nn.silu(c), jax.nn.silu(c_ctx)
    for l in range(DEPTH):
        with_ctx = l < DEPTH - 1
        mod_l = jnp.split((sc @ w_ada[l] + b_ada[l])[:, None, :], 6, axis=-1)
        mod_c = jnp.split(scc @ w_ada[l] + b_ada[l], 6, axis=-1)

        lam_init = 0.8 - 0.6 * math.exp(-0.3 * l)
        lam = (jnp.exp(jnp.sum(lam_q1[l].astype(jnp.float32) * lam_k1[l].astype(jnp.float32)))
               - jnp.exp(jnp.sum(lam_q2[l].astype(jnp.float32) * lam_k2[l].astype(jnp.float32))) + lam_init)
        hl = xl * (1.0 + mod_l[1]) + mod_l[0]
        hc = xc * (1.0 + mod_c[1]) + mod_c[0]
        mix_l, mix_c = token_mixer(hl, hc, row, col, lam, lam_init, with_ctx, w_in[l], subln_g[l], rkv_conv[l],
                                   decay_w0[l], decay_up[l], iclr_a0[l], iclr_up[l], gate_up[l], k_k[l], k_a[l],
                                   r_k[l], gn_g[l], gn_b[l], conv_w[l], w_out[l])
        xl = layer_norm(DN_ALPHA * xl + mod_l[2] * mix_l, ln1_g[l], ln1_b[l])
        if with_ctx:
            xc = layer_norm(DN_ALPHA * xc + mod_c[2] * mix_c, ln1_g[l], ln1_b[l])

        def channel_mixer(h):
            j = l // 2
            if l % 2 == 0:
                return swiglu(h, ffn_w1[j], ffn_w3[j], ffn_w2[j])
            return moe_swiglu(h, router_w[j], router_b[j], moe_w1[j], moe_w3[j], moe_w2[j])

        hl = xl * (1.0 + mod_l[4]) + mod_l[3]
        xl = layer_norm(DN_ALPHA * xl + mod_l[5] * channel_mixer(hl), ln2_g[l], ln2_b[l])
        if with_ctx:
            hc = xc * (1.0 + mod_c[4]) + mod_c[3]
            xc = layer_norm(DN_ALPHA * xc + mod_c[5] * channel_mixer(hc), ln2_g[l], ln2_b[l])
    return xl
```

```cpp
#include <hip/hip_runtime.h>
#define REP_MASK 0
#include <cstdio>
#include <cstdint>

#define LAS __attribute__((address_space(3)))
typedef unsigned short bf16_t;
typedef short bf16x8 __attribute__((ext_vector_type(8)));
typedef float f32x4 __attribute__((ext_vector_type(4)));
typedef float f32x2 __attribute__((ext_vector_type(2)));
typedef unsigned u32x4 __attribute__((ext_vector_type(4)));
typedef unsigned u32x2 __attribute__((ext_vector_type(2)));
typedef short bf16x4s __attribute__((ext_vector_type(4)));
#define BF4(v) __builtin_bit_cast(bf16x4s, (v))

constexpr int NB = 8, T = 4096, CT = 256, D = 1024, DEPTH = 4, GW = 64;
constexpr int BT = NB * T, BC = NB * CT, M = BT + BC;
constexpr int NPROJ = 3264, NPROJP = 3328;
constexpr int OQ = 0, OK_ = 512, OV = 1024;
constexpr int ORR = 0, ORK = 256, ORV = 512, OWD = 768, OAD = 832, OGD = 896, OCH = 960, OCB = 1216, OCC = 1472;
constexpr int DFF = 2816, NE = 8, DFFE = 1408;
constexpr int MPADMAX = 2 * M + NE * 256;
constexpr float DN_ALPHA = 1.681792830507429f;
constexpr float LN_EPS = 1e-5f, SUBLN_EPS = 1e-5f, GN_EPS = 64e-5f;
constexpr float LOG2E = 1.4426950408889634f;

constexpr size_t MiB = 1u << 20;
constexpr size_t WS_CTL = 0, CTL_ZERO_BYTES = 1 * MiB;
constexpr size_t WS_MODS = 1 * MiB;
constexpr size_t WS_LAM = WS_MODS + 960 * 1024;
constexpr size_t WS_LW = WS_MODS + 884736;
constexpr size_t WS_WIN = 2 * MiB;
constexpr size_t WS_WOUT = WS_WIN + 6 * MiB + MiB / 2;
constexpr size_t WS_WFF = WS_WOUT + 2 * MiB;
constexpr size_t WS_WFF2 = WS_WFF + 44 * MiB;
constexpr size_t WS_XSC = WS_WFF + 66 * MiB;
constexpr size_t WS_ACT = WS_XSC + 8 * MiB;
constexpr size_t WS_R1 = WS_ACT + 68 * MiB;
constexpr size_t WS_QKV = WS_R1, WS_REST = WS_R1 + 102 * MiB;
constexpr int LDQ = 1536, LDR = 1792;
constexpr size_t WS_R2 = WS_R1 + 221 * MiB;
constexpr size_t RWSZ = (size_t)M * 256 * 2;
constexpr size_t WS_CH = WS_R1;
constexpr size_t WS_KV = WS_R2 + 10 * RWSZ;
constexpr size_t WS_YD = WS_KV;
constexpr size_t WS_BONUS = WS_KV + 68 * MiB;
constexpr size_t WS_MISC = WS_R2 + 239 * MiB;
constexpr size_t WS_TOPE = WS_MISC, WS_TOPG = WS_MISC + 256 * 1024, WS_SLOT = WS_MISC + 640 * 1024;
constexpr size_t WS_TOK = WS_MISC + 1 * MiB;
constexpr size_t WS_END = WS_MISC + 2 * MiB;
static_assert(WS_BONUS + (size_t)M * 16 <= WS_MISC, "ws map");
static_assert((size_t)MPADMAX * 1024 * 2 <= 239 * MiB && (size_t)MPADMAX * DFFE * 2 <= 221 * MiB, "moe buffers");
static_assert((size_t)M * LDQ * 2 == 102 * MiB && (size_t)M * LDR * 2 <= 119 * MiB && 2 * RWSZ <= 68 * MiB && (size_t)64 * 272 * 12544 <= 221 * MiB, "R1 split");
enum { RW_V = 0, RW_G = 1 };
constexpr int CW_BAR = 4096;
constexpr int CW_CNT = 8192, CW_CUR = 8192 + 256, CW_ATT = 8192 + 512;

__host__ __device__ constexpr size_t ch_off_c(int chain) { return chain < 31 ? WS_R1 + (size_t)chain * 272 * 12544 : WS_R2 + 34 * MiB + (size_t)(chain - 31) * 272 * 12544; }
static_assert(ch_off_c(31) == WS_R2 + 34 * MiB && (size_t)31 * 272 * 12544 <= 102 * MiB && 34 * MiB + (size_t)33 * 272 * 12544 <= 170 * MiB, "chunk-record placement: part A over the dead QKV buffer, part B between the V/G arrays and the KV images");
__device__ __forceinline__ unsigned f2bf(float f) { unsigned u = __builtin_bit_cast(unsigned, f); return (u + 0x7fffu + ((u >> 16) & 1u)) >> 16; }
__device__ __forceinline__ unsigned pk2(float lo, float hi) { return f2bf(lo) | (f2bf(hi) << 16); }
typedef __bf16 bf16x2_t __attribute__((ext_vector_type(2)));
__device__ __forceinline__ unsigned cvtpk(float lo, float hi) { const f32x2 v = {lo, hi}; return __builtin_bit_cast(unsigned, __builtin_convertvector(v, bf16x2_t)); }
__device__ __forceinline__ float bf2f(unsigned short h) { return __builtin_bit_cast(float, (unsigned)h << 16); }
__device__ __forceinline__ float bflo(unsigned w) { return __builtin_bit_cast(float, w << 16); }
__device__ __forceinline__ float bfhi(unsigned w) { return __builtin_bit_cast(float, w & 0xffff0000u); }
__device__ __forceinline__ float rdl(float x, int k) { return __builtin_bit_cast(float, __builtin_amdgcn_readlane(__builtin_bit_cast(int, x), k)); }
#define DPP_ADD(v, ctrl) ((v) + __builtin_bit_cast(float, __builtin_amdgcn_update_dpp(0, __builtin_bit_cast(int, (v)), (ctrl), 0xf, 0xf, true)))
__device__ __forceinline__ float wave_sum(float v) {
    v = DPP_ADD(v, 0xB1);
    v = DPP_ADD(v, 0x4E);
    v = DPP_ADD(v, 0x141);
    v = DPP_ADD(v, 0x140);
    return (rdl(v, 0) + rdl(v, 16)) + (rdl(v, 32) + rdl(v, 48));
}
__device__ __forceinline__ float wave_max(float v) {
#pragma unroll
    for (int o = 1; o < 64; o <<= 1) v = fmaxf(v, __shfl_xor(v, o));
    return v;
}
__device__ __forceinline__ float sigmoidf_(float x) { return __builtin_amdgcn_rcpf(1.0f + __builtin_amdgcn_exp2f(-LOG2E * x)); }

namespace pg8 {
#define PG8_LAS __attribute__((address_space(3)))
constexpr int BM = 256, BK = 64, HALF = 128, HTB = HALF * BK * 2, STAGE_BYTES = 8 * HTB;
__host__ __device__ __forceinline__ int lds_byte(int r, int c) { const int st = (r >> 4) * 2 + (c >> 5), rr = r & 15, cc = c & 31, ob = rr * 64 + cc * 2; return st * 1024 + (ob ^ (((ob >> 9) & 1) << 5)); }
__host__ __device__ __forceinline__ void stage_rc(int b, int& R, int& C) { const int st = b / 1024, sb = b % 1024, swz = sb ^ (((sb >> 9) & 1) << 5); R = (st >> 1) * 16 + swz / 64; C = (st & 1) * 32 + (swz % 64) / 2; }
__host__ __device__ __forceinline__ int perm32(int rho) { const int n = rho >> 4, i = rho & 15; return 8 * (i >> 2) + 4 * n + (i & 3); }

struct Unit { int pm, pn, e, k0, nk, ks; };
struct Gemm { const bf16_t* A; const bf16_t* Bt; int K; size_t estride; };

struct StaticOrder {
    static constexpr bool KSPLIT = false, GATHER = false;
    int nM, nN, nwg, G, c;
    __device__ void init(int Mrows, int N, int G_, int c_) { nM = Mrows / BM; nN = N / BM; nwg = nM * nN; G = G_; c = c_; }
    __device__ bool next(int i, Unit& u) const {
        int L = i * G + c; if (L >= nwg) return false;
        { const int q = nwg / 8, r = nwg % 8, xcd = L % 8, off = L / 8; L = (xcd < r ? xcd * (q + 1) : r * (q + 1) + (xcd - r) * q) + off; }
        const int nig = 8 * nN, gid = L / nig, fm = gid * 8, gsz = (nM - fm) < 8 ? (nM - fm) : 8;
        u.pm = fm + ((L % nig) % gsz); u.pn = (L % nig) / gsz; u.e = 0; u.k0 = 0; u.nk = 0; u.ks = 0; return true;
    }
};
struct MoeOrder {
    static constexpr bool KSPLIT = false, GATHER = false;
    int tb[NE + 1]; int nN, nwg, G, c;
    __device__ void init(const unsigned* cnt, int N, int G_, int c_) {
        int t = 0;
#pragma unroll
        for (int e = 0; e < NE; ++e) { tb[e] = t; t += (int)((__hip_atomic_load(cnt + e, __ATOMIC_RELAXED, __HIP_MEMORY_SCOPE_AGENT) + 255u) >> 8); }
        tb[NE] = t; nN = N / BM; nwg = t * nN; G = G_; c = c_;
    }
    __device__ bool next(int i, Unit& u) const {
        int L = i * G + c; if (L >= nwg) return false;
        { const int q = nwg / 8, r = nwg % 8, xcd = L % 8, off = L / 8; L = (xcd < r ? xcd * (q + 1) : r * (q + 1) + (xcd - r) * q) + off; }
        u.pm = L / nN; u.pn = L % nN; int e = 0;
#pragma unroll
        for (int k = 1; k < NE; ++k) e += (u.pm >= tb[k]) ? 1 : 0;
        u.e = e; u.k0 = 0; u.nk = 0; u.ks = 0; return true;
    }
};

struct SplitOrder {
    static constexpr bool KSPLIT = true, GATHER = false;
    int nN, nL, nC, S, NT, G, c;
    __device__ void init(int N, int S_, int NT_, bool with_ctx, int G_, int c_) { nN = N / BM; nL = (BT / BM) * nN; S = S_; NT = NT_; nC = with_ctx ? (BC / BM) * nN * S_ : 0; G = G_; c = c_; }
    __device__ bool next(int i, Unit& u) const {
        const int L0 = i * G + c; if (L0 >= nL + nC) return false;
        int pm, pn, k0 = 0, nk = NT, ks = 0;
        if (L0 < nL) { int L = L0; { const int q = nL / 8, r = nL % 8, xcd = L % 8, off = L / 8; L = (xcd < r ? xcd * (q + 1) : r * (q + 1) + (xcd - r) * q) + off; }
            const int nig = 8 * nN, gid = L / nig, fm = gid * 8; pm = fm + ((L % nig) & 7); pn = (L % nig) >> 3; }
        else { const int idx = L0 - nL, q = idx / S; ks = idx - q * S; pn = q % nN; pm = BT / BM + q / nN; nk = NT / S; k0 = ks * nk; }
        u.pm = pm; u.pn = pn; u.e = 0; u.k0 = k0; u.nk = nk; u.ks = ks; return true;
    }
};
struct MoeGatherOrder : MoeOrder {
    static constexpr bool GATHER = true;
    const int* tok;
    __device__ __forceinline__ int row_of(int slot) const { return tok[slot]; }
};
__device__ __forceinline__ unsigned cvt_pk_bf16(float lo, float hi) { unsigned r; asm volatile("v_cvt_pk_bf16_f32 %0, %1, %2" : "=v"(r) : "v"(lo), "v"(hi)); return r; }

struct EpiBf16 {
    static constexpr bool PERM = true;
    bf16_t* O; int ldc; bf16_t* O1; int ldc1; int psplit;
    __device__ __forceinline__ void operator()(const f32x4 (&acc)[2][2][4][2], const Unit& u, int wr, int wc, int fr, int fq) const {
        const bool second = psplit > 0 && u.pn >= psplit;
        bf16_t* base = second ? O1 : O; const int ld = second ? ldc1 : ldc;
        const int row0 = u.pm * BM + wr * 64 + fr, col0 = (second ? u.pn - psplit : u.pn) * BM + wc * 32 + 8 * fq;
#pragma unroll
        for (int ai = 0; ai < 2; ++ai)
#pragma unroll
            for (int m = 0; m < 4; ++m) { bf16_t* rowp = base + (size_t)(row0 + ai * HALF + m * 16) * ld + col0;
#pragma unroll
                for (int bj = 0; bj < 2; ++bj) { const f32x4 v0 = acc[ai][bj][m][0], v1 = acc[ai][bj][m][1];
                    u32x4 w; w.x = cvt_pk_bf16(v0[0], v0[1]); w.y = cvt_pk_bf16(v0[2], v0[3]); w.z = cvt_pk_bf16(v1[0], v1[1]); w.w = cvt_pk_bf16(v1[2], v1[3]);
                    *(u32x4*)(rowp + bj * HALF) = w; } }
    }
};
struct EpiSwiGLU {
    static constexpr bool PERM = true;
    bf16_t* H; int ldh;
    __device__ __forceinline__ void operator()(const f32x4 (&acc)[2][2][4][2], const Unit& u, int wr, int wc, int fr, int fq) const {
        const int row0 = u.pm * BM + wr * 64 + fr, h0 = u.pn * 128 + wc * 16 + 4 * fq;
#pragma unroll
        for (int ai = 0; ai < 2; ++ai)
#pragma unroll
            for (int m = 0; m < 4; ++m) { bf16_t* rowp = H + (size_t)(row0 + ai * HALF + m * 16) * ldh + h0;
#pragma unroll
                for (int bj = 0; bj < 2; ++bj) { const f32x4 g = acc[ai][bj][m][0], up = acc[ai][bj][m][1]; f32x4 o;
#pragma unroll
                    for (int j = 0; j < 4; ++j) o[j] = g[j] * __builtin_amdgcn_rcpf(1.0f + __builtin_amdgcn_exp2f(-LOG2E * g[j])) * up[j];
                    u32x2 w; w.x = cvt_pk_bf16(o[0], o[1]); w.y = cvt_pk_bf16(o[2], o[3]);
                    *(u32x2*)(rowp + bj * 64) = w; } }
    }
};
struct EpiResid {
    static constexpr bool PERM = false;
    float* lat; float* ctx; const float* gates;
    __device__ __forceinline__ void operator()(const f32x4 (&acc)[2][2][4][2], const Unit& u, int wr, int wc, int fr, int fq) const {
        const int bb = u.pm < (BT / BM) ? u.pm / (T / BM) : NB;
        float* base = u.pm < (BT / BM) ? lat + (size_t)u.pm * BM * D : ctx + (size_t)(u.pm - BT / BM) * BM * D;
        const int row0 = wr * 64 + fr, col0 = u.pn * BM + wc * 32 + 4 * fq;
        const float* gp = gates + (size_t)bb * 6 * D + col0;
        f32x4 gv[2][2];
#pragma unroll
        for (int bj = 0; bj < 2; ++bj)
#pragma unroll
            for (int n = 0; n < 2; ++n) gv[bj][n] = *(const f32x4*)(gp + bj * HALF + n * 16);
        f32x4 xc[2][2], xn[2][2];
#pragma unroll
        for (int bj = 0; bj < 2; ++bj)
#pragma unroll
            for (int n = 0; n < 2; ++n) xc[bj][n] = *(const f32x4*)(base + (size_t)row0 * D + col0 + bj * HALF + n * 16);
#pragma unroll
        for (int i = 0; i < 8; ++i) { const int ai = i >> 2, m = i & 3; float* rowp = base + (size_t)(row0 + ai * HALF + m * 16) * D + col0;
            if (i < 7) { const float* nrow = base + (size_t)(row0 + ((i + 1) >> 2) * HALF + ((i + 1) & 3) * 16) * D + col0;
#pragma unroll
                for (int bj = 0; bj < 2; ++bj)
#pragma unroll
                    for (int n = 0; n < 2; ++n) xn[bj][n] = *(const f32x4*)(nrow + bj * HALF + n * 16); }
#pragma unroll
            for (int bj = 0; bj < 2; ++bj)
#pragma unroll
                for (int n = 0; n < 2; ++n) { *(f32x4*)(rowp + bj * HALF + n * 16) = xc[bj][n] + gv[bj][n] * acc[ai][bj][m][n]; xc[bj][n] = xn[bj][n]; }
            asm volatile("" ::: "memory"); }
    }
};

struct EpiDelta {
    static constexpr bool PERM = true;
    bf16_t* O; const float* gates; bf16_t* Oc;
    __device__ __forceinline__ void operator()(const f32x4 (&acc)[2][2][4][2], const Unit& u, int wr, int wc, int fr, int fq) const {
        const int bb = u.pm < (BT / BM) ? u.pm / (T / BM) : NB;
        const int row0 = u.pm * BM + wr * 64 + fr, col0 = u.pn * BM + wc * 32 + 8 * fq;
        bf16_t* Ob = u.ks > 0 ? Oc + ((long)(u.ks - 1) * BC - BT) * (long)D : O;
        const float* gp = gates + (size_t)bb * 6 * D + col0;
        f32x4 gv[2][2];
#pragma unroll
        for (int bj = 0; bj < 2; ++bj)
#pragma unroll
            for (int n = 0; n < 2; ++n) gv[bj][n] = *(const f32x4*)(gp + bj * HALF + 4 * n);
#pragma unroll
        for (int ai = 0; ai < 2; ++ai)
#pragma unroll
            for (int m = 0; m < 4; ++m) { bf16_t* rowp = Ob + (size_t)(row0 + ai * HALF + m * 16) * D + col0;
#pragma unroll
                for (int bj = 0; bj < 2; ++bj) { const f32x4 v0 = acc[ai][bj][m][0] * gv[bj][0], v1 = acc[ai][bj][m][1] * gv[bj][1];
                    u32x4 w; w.x = cvt_pk_bf16(v0[0], v0[1]); w.y = cvt_pk_bf16(v0[2], v0[3]); w.z = cvt_pk_bf16(v1[0], v1[1]); w.w = cvt_pk_bf16(v1[2], v1[3]);
                    *(u32x4*)(rowp + bj * HALF) = w; } }
    }
};
template <class Epi, class Sched, bool ALIGN_EPI = true, bool SP2 = true>
__device__ __forceinline__ void gemm_phase(PG8_LAS unsigned char* lds, const Gemm g, const Sched& S, const Epi& E, int wave_) {
    unsigned z_ = 0u; asm volatile("" : "+v"(z_)); int tid_ = (wave_ << 6) | (int)__builtin_amdgcn_mbcnt_hi(~0u, __builtin_amdgcn_mbcnt_lo(~0u, z_)); asm volatile("" : "+v"(tid_));
    static_assert(!Sched::GATHER || SP2, "row-table A loads are wired into the SP2 schedule only");
    const int tid = tid_, wid = __builtin_amdgcn_readfirstlane(tid >> 6), lane = tid & 63, wr = wid >> 2, wc = wid & 3, fr = lane & 15, fq = lane >> 4;
    const int K = g.K, nt = K / BK;
    unsigned voffA[2], voffB[2];
#pragma unroll
    for (int i = 0; i < 2; ++i) { int R, C; stage_rc(tid * 16 + i * 8192, R, C); const int Rb = Epi::PERM ? ((R & ~31) + perm32(R & 31)) : R;
        voffA[i] = (unsigned)(R * K + C) * 2u; voffB[i] = (unsigned)(Rb * K + C) * 2u; }
    const size_t kstep = (size_t)(BK * 2);
    constexpr bool GA = Sched::GATHER;
    unsigned gvo[2][2];
    PG8_LAS unsigned* gstash = (PG8_LAS unsigned*)(lds + STAGE_BYTES);
    const size_t hstep = (size_t)HALF * K * 2;
    const size_t tstep = 2 * hstep;
    const unsigned ldsw = (unsigned)wid * 1024u;
    const int aoff = lds_byte(wr * 64 + fr, fq * 8), boff = lds_byte(wc * 32 + fr, fq * 8);
#define PG8_SA(b, h) (((b) * 2 + (h)) * HTB)
#define PG8_SB(b, h) ((4 + (b) * 2 + (h)) * HTB)
#define PG8_STAGE(bufoff, gbase, voff) do { _Pragma("unroll") for (int _i = 0; _i < 2; ++_i) \
        __builtin_amdgcn_global_load_lds((const unsigned*)((const char*)(gbase) + (voff)[_i]), (PG8_LAS unsigned*)(lds + (bufoff) + ldsw + _i * 8192), 16, 0, 0); } while (0)
#define PG8_LDA(dst, b, h) do { _Pragma("unroll") for (int m = 0; m < 4; ++m) _Pragma("unroll") for (int k = 0; k < 2; ++k) dst[m][k] = *(const PG8_LAS bf16x8*)(lds + PG8_SA(b, h) + aoff + m * 2048 + k * 1024); } while (0)
#define PG8_LDB(dst, b, h) do { _Pragma("unroll") for (int n = 0; n < 2; ++n) _Pragma("unroll") for (int k = 0; k < 2; ++k) dst[n][k] = *(const PG8_LAS bf16x8*)(lds + PG8_SB(b, h) + boff + n * 2048 + k * 1024); } while (0)
#define PG8_MMA(ai, bj, At, Bt) do { __builtin_amdgcn_s_setprio(1); _Pragma("unroll") for (int m = 0; m < 4; ++m) _Pragma("unroll") for (int n = 0; n < 2; ++n) _Pragma("unroll") for (int k = 0; k < 2; ++k) \
        acc[ai][bj][m][n] = __builtin_amdgcn_mfma_f32_16x16x32_bf16(Bt[n][k], At[m][k], acc[ai][bj][m][n], 0, 0, 0); __builtin_amdgcn_s_setprio(0); } while (0)
#define PG8_WAIT_V(n) asm volatile("s_waitcnt vmcnt(" #n ")" ::: "memory")
#define PG8_WAIT_L(n) asm volatile("s_waitcnt lgkmcnt(" #n ")" ::: "memory")
#define PG8_BAR __builtin_amdgcn_s_barrier()
#define PG8_SCHED __builtin_amdgcn_sched_barrier(0)
    Unit cur, nxt; int ui = 0;
    if (!S.next(0, cur)) return;
    f32x4 acc[2][2][4][2];
#pragma unroll
    for (int a = 0; a < 2; ++a)
#pragma unroll
        for (int b = 0; b < 2; ++b)
#pragma unroll
            for (int m = 0; m < 4; ++m)
#pragma unroll
                for (int n = 0; n < 2; ++n) acc[a][b][m][n] = (f32x4){0.f, 0.f, 0.f, 0.f};
    bf16x8 At[4][2], B0[2][2], B1[2][2];
#define PG8_GDMA(u) do { _Pragma("unroll") for (int h_ = 0; h_ < 2; ++h_) _Pragma("unroll") for (int i_ = 0; i_ < 2; ++i_) { int R_, C_; stage_rc(tid * 16 + i_ * 8192, R_, C_); \
        __builtin_amdgcn_global_load_lds((const unsigned*)(S.tok + ((u).pm * BM + h_ * HALF + R_)), (PG8_LAS unsigned*)(gstash + (h_ * 2 + i_) * 512 + wid * 64), 4, 0, 0); } } while (0)
#define PG8_GREAD(o) do { _Pragma("unroll") for (int h_ = 0; h_ < 2; ++h_) _Pragma("unroll") for (int i_ = 0; i_ < 2; ++i_) { int R_, C_; stage_rc(tid * 16 + i_ * 8192, R_, C_); \
        o[h_][i_] = (gstash[(h_ * 2 + i_) * 512 + tid] * (unsigned)K + (unsigned)C_) * 2u; } } while (0)
#define PG8_STAGE_A(bufoff, ptr, h, VO) do { if constexpr (GA) { PG8_STAGE(bufoff, ptr, (VO)[h]); } else { PG8_STAGE(bufoff, (ptr) + (h) * hstep, voffA); } } while (0)
#define PG8_STAGE_AS(bufoff, ptr, h) do { if constexpr (GA) { if (last) { unsigned vs_[2]; _Pragma("unroll") for (int i_ = 0; i_ < 2; ++i_) { int R_, C_; stage_rc(tid * 16 + i_ * 8192, R_, C_); vs_[i_] = (gstash[((h) * 2 + i_) * 512 + tid] * (unsigned)K + (unsigned)C_) * 2u; } PG8_STAGE(bufoff, ptr, vs_); } \
        else { PG8_STAGE(bufoff, ptr, gvo[h]); } } else { PG8_STAGE(bufoff, (ptr) + (h) * hstep, voffA); } } while (0)
    if constexpr (GA) { PG8_GDMA(cur); PG8_WAIT_V(0); PG8_GREAD(gvo); PG8_WAIT_L(0); }
    const char* cA = (const char*)g.A + (GA ? (size_t)0 : (size_t)cur.pm * tstep); const char* cB = (const char*)g.Bt + (size_t)cur.e * g.estride + (size_t)cur.pn * tstep;
    if constexpr (Sched::KSPLIT) { cA += (size_t)cur.k0 * kstep; cB += (size_t)cur.k0 * kstep; }
    if constexpr (SP2) {
        PG8_STAGE(PG8_SB(0, 0), cB, voffB); PG8_STAGE(PG8_SB(0, 1), cB + hstep, voffB); PG8_STAGE_A(PG8_SA(0, 0), cA, 0, gvo); PG8_STAGE_A(PG8_SA(0, 1), cA, 1, gvo);
        if (wr == 1) PG8_BAR;
        PG8_WAIT_V(2); PG8_BAR;
        PG8_STAGE(PG8_SB(1, 0), cB + kstep, voffB); PG8_STAGE_A(PG8_SA(1, 0), cA + kstep, 0, gvo); PG8_STAGE(PG8_SB(1, 1), cB + hstep + kstep, voffB);
        PG8_WAIT_V(6); PG8_BAR;
    } else {
        PG8_STAGE(PG8_SB(0, 0), cB, voffB); PG8_STAGE(PG8_SA(0, 0), cA, voffA); PG8_STAGE(PG8_SB(0, 1), cB + hstep, voffB); PG8_STAGE(PG8_SA(0, 1), cA + hstep, voffA);
        if (wr == 1) PG8_BAR;
        PG8_WAIT_V(4); PG8_BAR;
        PG8_STAGE(PG8_SB(1, 0), cB + kstep, voffB); PG8_STAGE(PG8_SA(1, 0), cA + kstep, voffA); PG8_STAGE(PG8_SB(1, 1), cB + hstep + kstep, voffB);
        PG8_WAIT_V(6); PG8_BAR;
    }
    for (;;) {
        const bool has_next = S.next(ui + 1, nxt);
        if constexpr (GA) { if (has_next) PG8_GDMA(nxt); }
        const char* nA = GA ? (const char*)g.A : (has_next ? (const char*)g.A + (size_t)nxt.pm * tstep : cA); const char* nB = has_next ? (const char*)g.Bt + (size_t)nxt.e * g.estride + (size_t)nxt.pn * tstep : cB;
        if constexpr (Sched::KSPLIT) { if (has_next) { nA += (size_t)nxt.k0 * kstep; nB += (size_t)nxt.k0 * kstep; } }
        const int ntu = Sched::KSPLIT ? cur.nk : nt;
        for (int t = 0; t < ntu; t += 2) {
            const bool last = (t == ntu - 2);
            const char* a1 = cA + (size_t)(t + 1) * kstep;
            const char* a2 = last ? nA : cA + (size_t)(t + 2) * kstep; const char* b2 = last ? nB : cB + (size_t)(t + 2) * kstep;
            const char* a3 = a2 + kstep; const char* b3 = b2 + kstep;
            if constexpr (SP2) {
            PG8_LDB(B0, 0, 0); PG8_LDB(B1, 0, 1); PG8_SCHED; PG8_LDA(At, 0, 0); PG8_STAGE_A(PG8_SA(1, 1), a1, 1, gvo);
            PG8_WAIT_V(8); PG8_WAIT_L(0); PG8_BAR; PG8_MMA(0, 0, At, B0); PG8_MMA(0, 1, At, B1); PG8_BAR; PG8_SCHED;
            PG8_LDA(At, 0, 1); PG8_STAGE(PG8_SB(0, 0), b2, voffB); PG8_STAGE(PG8_SB(0, 1), b2 + hstep, voffB); PG8_STAGE_AS(PG8_SA(0, 0), a2, 0);
            PG8_WAIT_V(8); PG8_WAIT_L(0); PG8_BAR; PG8_MMA(1, 0, At, B0); PG8_MMA(1, 1, At, B1); PG8_BAR; PG8_SCHED;
            PG8_LDB(B0, 1, 0); PG8_LDB(B1, 1, 1); PG8_SCHED; PG8_LDA(At, 1, 0); PG8_STAGE_AS(PG8_SA(0, 1), a2, 1);
            PG8_WAIT_V(8); PG8_WAIT_L(0); PG8_BAR; PG8_MMA(0, 0, At, B0); PG8_MMA(0, 1, At, B1); PG8_BAR; PG8_SCHED;
            PG8_LDA(At, 1, 1); PG8_STAGE(PG8_SB(1, 0), b3, voffB); PG8_STAGE(PG8_SB(1, 1), b3 + hstep, voffB); PG8_STAGE_AS(PG8_SA(1, 0), a3, 0);
            PG8_WAIT_V(8); PG8_WAIT_L(0); PG8_BAR; PG8_MMA(1, 0, At, B0); PG8_MMA(1, 1, At, B1); PG8_BAR; PG8_SCHED;
            } else {
            PG8_LDB(B0, 0, 0); PG8_SCHED; PG8_LDA(At, 0, 0); PG8_STAGE(PG8_SA(1, 1), a1 + hstep, voffA);
            PG8_WAIT_L(8); PG8_BAR; PG8_WAIT_L(0); PG8_MMA(0, 0, At, B0); PG8_BAR; PG8_SCHED;
            PG8_LDB(B1, 0, 1); PG8_STAGE(PG8_SB(0, 0), b2, voffB);
            PG8_BAR; PG8_WAIT_L(0); PG8_MMA(0, 1, At, B1); PG8_BAR;
            PG8_LDA(At, 0, 1); PG8_STAGE(PG8_SA(0, 0), a2, voffA);
            PG8_BAR; PG8_WAIT_L(0); PG8_MMA(1, 0, At, B0); PG8_BAR; PG8_SCHED;
            PG8_STAGE(PG8_SB(0, 1), b2 + hstep, voffB);
            PG8_WAIT_V(6); PG8_BAR; PG8_MMA(1, 1, At, B1); PG8_BAR;
            PG8_LDB(B0, 1, 0); PG8_SCHED; PG8_LDA(At, 1, 0); PG8_STAGE(PG8_SA(0, 1), a2 + hstep, voffA);
            PG8_WAIT_L(8); PG8_BAR; PG8_WAIT_L(0); PG8_MMA(0, 0, At, B0); PG8_BAR; PG8_SCHED;
            PG8_LDB(B1, 1, 1); PG8_STAGE(PG8_SB(1, 0), b3, voffB);
            PG8_BAR; PG8_WAIT_L(0); PG8_MMA(0, 1, At, B1); PG8_BAR;
            PG8_LDA(At, 1, 1); PG8_STAGE(PG8_SA(1, 0), a3, voffA);
            PG8_BAR; PG8_WAIT_L(0); PG8_MMA(1, 0, At, B0); PG8_BAR; PG8_SCHED;
            PG8_STAGE(PG8_SB(1, 1), b3 + hstep, voffB);
            PG8_WAIT_V(6); PG8_BAR; PG8_MMA(1, 1, At, B1); PG8_BAR;
            }
        }
        if constexpr (ALIGN_EPI) { if (wr == 0) PG8_BAR; }
        E(acc, cur, wr, wc, fr, fq);
        if (!has_next) break;
#pragma unroll
        for (int a = 0; a < 2; ++a)
#pragma unroll
            for (int b = 0; b < 2; ++b)
#pragma unroll
                for (int m = 0; m < 4; ++m)
#pragma unroll
                    for (int n = 0; n < 2; ++n) acc[a][b][m][n] = (f32x4){0.f, 0.f, 0.f, 0.f};
        cur = nxt; cA = nA; cB = nB; ++ui;
        if constexpr (GA) { PG8_GREAD(gvo); PG8_WAIT_L(0); }
        if constexpr (ALIGN_EPI) { if (wr == 1) PG8_BAR; }
    }
    PG8_WAIT_V(0);
    if constexpr (!ALIGN_EPI) { if (wr == 0) PG8_BAR; }
    PG8_BAR;
#undef PG8_GDMA
#undef PG8_GREAD
#undef PG8_STAGE_A
#undef PG8_STAGE_AS
#undef PG8_SA
#undef PG8_SB
#undef PG8_STAGE
#undef PG8_LDA
#undef PG8_LDB
#undef PG8_MMA
#undef PG8_WAIT_V
#undef PG8_WAIT_L
#undef PG8_BAR
#undef PG8_SCHED
}
}

__device__ __forceinline__ int tid_of_wave(int wave) { unsigned z = 0u; asm volatile("" : "+v"(z)); return (wave << 6) | (int)__builtin_amdgcn_mbcnt_hi(~0u, __builtin_amdgcn_mbcnt_lo(~0u, z)); }
#define XB_TMO      128
#define XB_XCNT(j)  (256  + 64 * (j))
#define XB_XSUB(j)  (1280 + 64 * (j))
#define XB_XGEN(j)  (2304 + 64 * (j))
#define XB_TOP      3328
#define XB_TOPGEN   3392
#define XCD_BAR_WORDS 3456
#define XB_SPIN_CAP (1u << 18)
__device__ __forceinline__ unsigned xb_ld(unsigned* p)              { return __hip_atomic_load(p, __ATOMIC_RELAXED, __HIP_MEMORY_SCOPE_AGENT); }
__device__ __forceinline__ unsigned xb_add(unsigned* p, unsigned v) { return __hip_atomic_fetch_add(p, v, __ATOMIC_RELAXED, __HIP_MEMORY_SCOPE_AGENT); }
__device__ __forceinline__ unsigned xb_xcc_id() { return (unsigned)__builtin_amdgcn_s_getreg((3 << 11) | 20) & 0xFu; }
#define XB_SPIN(cond, bar) do { unsigned _sp = 0; while (cond) { __builtin_amdgcn_s_sleep(1); \
    if ((++_sp & 255u) == 0u) { if (xb_ld(&(bar)[XB_TMO])) break; if (_sp > XB_SPIN_CAP) { atomicAdd(&(bar)[XB_TMO], 1u); break; } } } } while (0)
struct XcdBarrier { unsigned* bar; unsigned x; volatile LAS unsigned* st; };
__device__ __forceinline__ XcdBarrier xcd_barrier_post(unsigned* bar, volatile LAS unsigned* st) {
    XcdBarrier b; b.bar = bar; b.x = xb_xcc_id(); b.st = st;
    if (threadIdx.x == 0) (void)xb_add(&bar[XB_XCNT(b.x)], 1u);
    return b;
}
__device__ __forceinline__ void xcd_barrier_complete(unsigned* bar, unsigned x, unsigned& nloc, unsigned& nx) {
    const unsigned G = gridDim.x * gridDim.y * gridDim.z;
    unsigned sum, cnt, mine, sp = 0u;
    for (;;) {
        sum = 0u; cnt = 0u; mine = 0u;
#pragma unroll
        for (unsigned j = 0; j < 16; ++j) { const unsigned c = xb_ld(&bar[XB_XCNT(j)]); sum += c; cnt += (c > 0u) ? 1u : 0u; mine = (j == x) ? c : mine; }
        if (sum == G) break;
        __builtin_amdgcn_s_sleep(1);
        if ((++sp & 255u) == 0u) { if (xb_ld(&bar[XB_TMO])) break; if (sp > XB_SPIN_CAP) { atomicAdd(&bar[XB_TMO], 1u); break; } }
    }
    nloc = mine > 0u ? mine : 1u; nx = cnt > 0u ? cnt : 1u;
}
__device__ __forceinline__ void xcd_barrier(const XcdBarrier& b, int wave) {
    asm volatile("s_waitcnt vmcnt(0)" ::: "memory");
    __syncthreads();
    if (tid_of_wave(wave) == 0) {
        unsigned* bar = b.bar;
        __builtin_amdgcn_s_waitcnt(0);
        unsigned nloc = b.st[0], nx = b.st[1];
        if (nloc == 0u) { xcd_barrier_complete(bar, b.x, nloc, nx); b.st[0] = nloc; b.st[1] = nx; }
        const unsigned old = xb_add(&bar[XB_XSUB(b.x)], 1u);
        const unsigned gen = old / nloc;
        if (old + 1u == (gen + 1u) * nloc) {
            __builtin_amdgcn_fence(__ATOMIC_RELEASE, "agent");
            asm volatile("s_waitcnt vmcnt(0)" ::: "memory");
            const unsigned og = xb_add(&bar[XB_TOP], 1u);
            const unsigned tg = og / nx;
            if (og + 1u == (tg + 1u) * nx) xb_add(&bar[XB_TOPGEN], 1u);
            else XB_SPIN(xb_ld(&bar[XB_TOPGEN]) == tg, bar);
            __builtin_amdgcn_fence(__ATOMIC_ACQUIRE, "agent");
            xb_add(&bar[XB_XGEN(b.x)], 1u);
            asm volatile("s_waitcnt vmcnt(0)" ::: "memory");
        } else {
            XB_SPIN(xb_ld(&bar[XB_XGEN(b.x)]) == gen, bar);
            __builtin_amdgcn_fence(__ATOMIC_ACQUIRE, "agent");
            asm volatile("s_waitcnt vmcnt(0)" ::: "memory");
        }
    }
    __syncthreads();
}

constexpr int NWAVES = 8, NTHR = 512;
constexpr int RING_BYTES = 131072, LDS_BYTES = 147456, MISC_OFF = LDS_BYTES - 256;
struct Args { const float* in[37]; float* out; unsigned char* ws; int s_lo, s_hi; };
enum { I_X = 0, I_C, I_CTX, I_CCTX, I_WADA, I_BADA, I_WIN, I_WOUT, I_LN1G, I_LN1B, I_LN2G, I_LN2B, I_LQ1, I_LK1, I_LQ2, I_LK2, I_SUBLN, I_RKVCONV, I_DW0, I_DUP, I_A0, I_AUP,
       I_GUP, I_KK, I_KA, I_RK, I_GNG, I_GNB, I_CONVW, I_FW1, I_FW3, I_FW2, I_RW, I_RB, I_MW1, I_MW3, I_MW2 };

struct Frame {
    LAS unsigned char* lds;
    unsigned* ctl;
    int tid, lane, wave, G, bid;
    const float* const* in; float* out; unsigned char* ws;
};
__device__ __forceinline__ float* xs_row(const Frame& F, int row) { return row < BT ? F.out + (size_t)row * D : (float*)(F.ws + WS_XSC) + (size_t)(row - BT) * D; }
__device__ __forceinline__ const float* mods_ptr(const Frame& F, int l, int bb, int idx) { return (const float*)(F.ws + WS_MODS) + ((size_t)(l * 9 + bb) * 6 + idx) * D; }

__device__ __forceinline__ Frame fresh(const Frame& F0) { Frame F = F0; int t = tid_of_wave(F0.wave); asm volatile("" : "+v"(t)); F.tid = t; F.lane = t & 63; return F; }

__device__ __forceinline__ void ph_mods(const Frame& F0, int l_lo, int l_hi, int vbid, int vG) {
    const Frame F = fresh(F0);
    LAS float* sc = (LAS float*)F.lds;
    LAS float* red = (LAS float*)(F.lds + 9 * 1024 * 4);
    const float* c = F.in[I_C]; const float* cc = F.in[I_CCTX];
    for (int i = F.tid; i < 9 * D; i += NTHR) { const float v = i < NB * D ? c[i] : cc[i - NB * D]; sc[i] = v / (1.0f + __expf(-v)); }
    __syncthreads();
    const int jgsub = F.wave >> 2, kq = F.wave & 3;
    for (int wi = vbid; wi < ((l_hi - l_lo) * 6 * D) / 128; wi += vG) {
        const int it = wi * 128 + jgsub * 64 + F.lane, l = l_lo + it / (6 * D), j = it % (6 * D);
        const float* w = F.in[I_WADA] + (size_t)l * D * 6 * D + j;
        float acc[9];
#pragma unroll
        for (int b = 0; b < 9; ++b) acc[b] = 0.f;
        for (int k0 = kq * 256; k0 < kq * 256 + 256; k0 += 16) { float wv[16];
#pragma unroll
            for (int u = 0; u < 16; ++u) wv[u] = w[(size_t)(k0 + u) * 6 * D];
#pragma unroll
            for (int u = 0; u < 16; ++u)
#pragma unroll
                for (int b = 0; b < 9; ++b) acc[b] += sc[b * D + k0 + u] * wv[u]; }
#pragma unroll
        for (int b = 0; b < 9; ++b) red[(F.wave * 9 + b) * 64 + F.lane] = acc[b];
        __syncthreads();
        if (kq == 0) {
            const float bias = F.in[I_BADA][l * 6 * D + j];
#pragma unroll
            for (int b = 0; b < 9; ++b) { const float s = red[((F.wave + 0) * 9 + b) * 64 + F.lane] + red[((F.wave + 1) * 9 + b) * 64 + F.lane] + red[((F.wave + 2) * 9 + b) * 64 + F.lane] + red[((F.wave + 3) * 9 + b) * 64 + F.lane];
                ((float*)(F.ws + WS_MODS))[(size_t)(l * 9 + b) * 6 * D + j] = s + bias; }
        }
        __syncthreads();
    }
    if (l_lo == 0 && vbid == 0 && F.tid < DEPTH) {
        const int l = F.tid; float s1 = 0.f, s2 = 0.f;
        for (int i = 0; i < 64; ++i) { s1 += F.in[I_LQ1][l * 64 + i] * F.in[I_LK1][l * 64 + i]; s2 += F.in[I_LQ2][l * 64 + i] * F.in[I_LK2][l * 64 + i]; }
        const float lam_init = 0.8f - 0.6f * expf(-0.3f * (float)l);
        ((float*)(F.ws + WS_LAM))[l] = expf(s1) - expf(s2) + lam_init;
    }
}

__device__ __forceinline__ void transpose_item(const float* W, int K, int N, bf16_t* WT, int kind, LAS float* scr, int item, int lane) {
    const int nblk = N / 32, kb = item / nblk, nb = item % nblk, k0 = 64 * kb, n0 = 32 * nb;
    f32x4 wv[8];
#pragma unroll
    for (int i = 0; i < 8; ++i) wv[i] = __builtin_nontemporal_load((const f32x4*)(W + (size_t)(k0 + i * 8 + (lane >> 3)) * N + n0 + 4 * (lane & 7)));
#pragma unroll
    for (int i = 0; i < 8; ++i) { LAS float* d = scr + (i * 8 + (lane >> 3)) * 33 + 4 * (lane & 7); d[0] = wv[i][0]; d[1] = wv[i][1]; d[2] = wv[i][2]; d[3] = wv[i][3]; }
    asm volatile("s_waitcnt lgkmcnt(0)" ::: "memory");
    const int c = lane & 7;
#pragma unroll
    for (int j = 0; j < 4; ++j) { const int n = (lane >> 3) + 8 * j; const LAS float* s = scr + (8 * c) * 33 + n;
        u32x4 o; o.x = pk2(s[0 * 33], s[1 * 33]); o.y = pk2(s[2 * 33], s[3 * 33]); o.z = pk2(s[4 * 33], s[5 * 33]); o.w = pk2(s[6 * 33], s[7 * 33]);
        const int ng = n0 + n; const int row = kind == 0 ? ng : ((ng >> 2) * 8 + (ng & 3) + (kind == 2 ? 4 : 0));
        *(u32x4*)(WT + (size_t)row * K + k0 + 8 * c) = o; }
    asm volatile("s_waitcnt lgkmcnt(0)" ::: "memory");
}
__device__ __forceinline__ void ph_convert(const Frame& F0, int l, int part, int vbid, int vG) {
    const Frame F = fresh(F0);
    if (part == 0) {
        const float* dup = F.in[I_DUP] + (size_t)l * 2 * 32 * 256; const float* aup = F.in[I_AUP] + (size_t)l * 2 * 32 * 256; const float* gup = F.in[I_GUP] + (size_t)l * 64 * 256;
        for (int p = vbid * NTHR + F.tid; p < 6 * 16 * 64; p += vG * NTHR) { const int ln = p & 63, ct = (p >> 6) & 15, win = p >> 10, m = ln & 15, g = ln >> 4, c = ct * 16 + m;
            const float* src = win < 2 ? dup + (size_t)win * 32 * 256 : (win < 4 ? aup + (size_t)(win - 2) * 32 * 256 : gup + (size_t)(win - 4) * 32 * 256);
            u32x4 w;
#pragma unroll
            for (int i = 0; i < 4; ++i) w[i] = pk2(src[(8 * g + 2 * i) * 256 + c], src[(8 * g + 2 * i + 1) * 256 + c]);
            *(u32x4*)(F.ws + WS_LW + (size_t)p * 16) = w; }
    }
    LAS float* scr = (LAS float*)(F.lds + 57344 + F.wave * 8704);
    const int gw = vbid * NWAVES + F.wave, NGW = vG * NWAVES;
    constexpr int I_IN = (D / 64) * (NPROJ / 32), I_OUT = (D / 64) * (D / 32);
    const int j = l >> 1;
    if ((l & 1) == 0) {
        constexpr int I_13 = (D / 64) * (DFF / 32), I_2 = (DFF / 64) * (D / 32);
        for (int it = gw + (part ? I_IN + I_OUT : 0); it < (part ? I_IN + I_OUT + 2 * I_13 + I_2 : I_IN + I_OUT); it += NGW) {
            int r = it;
            if (r < I_IN) { transpose_item(F.in[I_WIN] + (size_t)l * D * NPROJ, D, NPROJ, (bf16_t*)(F.ws + WS_WIN), 0, scr, r, F.lane); continue; } r -= I_IN;
            if (r < I_OUT) { transpose_item(F.in[I_WOUT] + (size_t)l * D * D, D, D, (bf16_t*)(F.ws + WS_WOUT), 0, scr, r, F.lane); continue; } r -= I_OUT;
            if (r < I_13) { transpose_item(F.in[I_FW1] + (size_t)j * D * DFF, D, DFF, (bf16_t*)(F.ws + WS_WFF), 1, scr, r, F.lane); continue; } r -= I_13;
            if (r < I_13) { transpose_item(F.in[I_FW3] + (size_t)j * D * DFF, D, DFF, (bf16_t*)(F.ws + WS_WFF), 2, scr, r, F.lane); continue; } r -= I_13;
            transpose_item(F.in[I_FW2] + (size_t)j * DFF * D, DFF, D, (bf16_t*)(F.ws + WS_WFF2), 0, scr, r, F.lane);
        }
    } else {
        constexpr int I_13 = (D / 64) * (DFFE / 32), I_2 = (DFFE / 64) * (D / 32);
        for (int it = gw + (part ? I_IN + I_OUT : 0); it < (part ? I_IN + I_OUT + NE * (2 * I_13 + I_2) : I_IN + I_OUT); it += NGW) {
            int r = it;
            if (r < I_IN) { transpose_item(F.in[I_WIN] + (size_t)l * D * NPROJ, D, NPROJ, (bf16_t*)(F.ws + WS_WIN), 0, scr, r, F.lane); continue; } r -= I_IN;
            if (r < I_OUT) { transpose_item(F.in[I_WOUT] + (size_t)l * D * D, D, D, (bf16_t*)(F.ws + WS_WOUT), 0, scr, r, F.lane); continue; } r -= I_OUT;
            const int e = r / (2 * I_13 + I_2); r -= e * (2 * I_13 + I_2);
            const size_t eo = (size_t)(j * NE + e);
            if (r < I_13) { transpose_item(F.in[I_MW1] + eo * D * DFFE, D, DFFE, (bf16_t*)(F.ws + WS_WFF) + (size_t)e * 2 * DFFE * D, 1, scr, r, F.lane); continue; } r -= I_13;
            if (r < I_13) { transpose_item(F.in[I_MW3] + eo * D * DFFE, D, DFFE, (bf16_t*)(F.ws + WS_WFF) + (size_t)e * 2 * DFFE * D, 2, scr, r, F.lane); continue; } r -= I_13;
            transpose_item(F.in[I_MW2] + eo * DFFE * D, DFFE, D, (bf16_t*)(F.ws + WS_WFF2) + (size_t)e * D * DFFE, 0, scr, r, F.lane);
        }
    }
}

template <int MODE>
__device__ __forceinline__ void ph_ln(const Frame& F0, int l, bool dry = false) {
    const Frame F = fresh(F0);
    constexpr int R = 4;
    const int gw = F.bid * NWAVES + F.wave, NGW = F.G * NWAVES;
    const int nrows = (MODE == 0 || l < DEPTH - 1) ? M : BT;
    const bool moe = (l & 1) != 0;
    const float* lg = F.in[MODE == 1 ? I_LN1G : I_LN2G] + l * D; const float* lb = F.in[MODE == 1 ? I_LN1B : I_LN2B] + l * D;
    const int lm = MODE == 2 ? l + 1 : l, si = MODE == 1 ? 3 : 0;
    bf16_t* ACT = (bf16_t*)(F.ws + WS_ACT);
    const int co = 4 * F.lane;
    for (int grp = gw; grp < nrows / R; grp += NGW) {
        const int row0 = grp * R, bb = row0 < BT ? row0 / T : NB;
        f32x4 v[R][4];
#pragma unroll
        for (int r = 0; r < R; ++r) { const int row = row0 + r;
            const bool fromin = MODE == 0 || (MODE == 1 && l == 0);
            const float* src = fromin ? (row < BT ? F.in[I_X] + (size_t)row * D : F.in[I_CTX] + (size_t)(row - BT) * D) : xs_row(F, row);
#pragma unroll
            for (int j = 0; j < 4; ++j) { v[r][j] = __builtin_nontemporal_load((const f32x4*)(src + co + 256 * j)); if (MODE == 1 && l == 0) v[r][j] = v[r][j] * DN_ALPHA; } }
        if (MODE == 1 || (MODE == 2 && !moe)) {
            const bf16_t* dl = (const bf16_t*)(F.ws + (MODE == 1 ? WS_R1 : WS_R2)) + (size_t)row0 * D + co;
            u32x2 dv[R][4];
#pragma unroll
            for (int r = 0; r < R; ++r)
#pragma unroll
                for (int j = 0; j < 4; ++j) dv[r][j] = __builtin_nontemporal_load((const u32x2*)(dl + (size_t)r * D + 256 * j));
#pragma unroll
            for (int r = 0; r < R; ++r)
#pragma unroll
                for (int j = 0; j < 4; ++j) { v[r][j][0] += bflo(dv[r][j].x); v[r][j][1] += bfhi(dv[r][j].x); v[r][j][2] += bflo(dv[r][j].y); v[r][j][3] += bfhi(dv[r][j].y); }
            if (row0 >= BT) {
                const int ns = MODE == 1 ? 4 : 2;
                for (int ks = 1; ks < ns; ++ks) { const bf16_t* pl = (const bf16_t*)(F.ws + (MODE == 1 ? WS_R1 : WS_R2) + 68 * MiB) + ((size_t)(ks - 1) * BC + (row0 - BT)) * D + co;
#pragma unroll
                    for (int r = 0; r < R; ++r)
#pragma unroll
                        for (int j = 0; j < 4; ++j) { const u32x2 x = *(const u32x2*)(pl + (size_t)r * D + 256 * j); v[r][j][0] += bflo(x.x); v[r][j][1] += bfhi(x.x); v[r][j][2] += bflo(x.y); v[r][j][3] += bfhi(x.y); } }
            }
        }
        if (MODE == 2 && moe) {
            const float* gate = mods_ptr(F, l, bb, 5);
            f32x4 gt[4];
#pragma unroll
            for (int j = 0; j < 4; ++j) gt[j] = *(const f32x4*)(gate + co + 256 * j);
            f32x2 tg[R]; int2 sl[R];
#pragma unroll
            for (int r = 0; r < R; ++r) { tg[r] = ((const f32x2*)(F.ws + WS_TOPG))[row0 + r]; sl[r] = ((const int2*)(F.ws + WS_SLOT))[row0 + r]; }
            u32x2 oa[R][4], ob[R][4];
#pragma unroll
            for (int r = 0; r < R; ++r) { const bf16_t* o0 = (const bf16_t*)(F.ws + WS_R2) + (size_t)sl[r].x * D, * o1 = (const bf16_t*)(F.ws + WS_R2) + (size_t)sl[r].y * D;
#pragma unroll
                for (int j = 0; j < 4; ++j) { oa[r][j] = __builtin_nontemporal_load((const u32x2*)(o0 + co + 256 * j)); ob[r][j] = __builtin_nontemporal_load((const u32x2*)(o1 + co + 256 * j)); } }
#pragma unroll
            for (int r = 0; r < R; ++r)
#pragma unroll
                for (int j = 0; j < 4; ++j) { const u32x2 a = oa[r][j], b = ob[r][j];
                    v[r][j][0] += gt[j][0] * (tg[r].x * bflo(a.x) + tg[r].y * bflo(b.x)); v[r][j][1] += gt[j][1] * (tg[r].x * bfhi(a.x) + tg[r].y * bfhi(b.x));
                    v[r][j][2] += gt[j][2] * (tg[r].x * bflo(a.y) + tg[r].y * bflo(b.y)); v[r][j][3] += gt[j][3] * (tg[r].x * bfhi(a.y) + tg[r].y * bfhi(b.y)); }
        }
        if (MODE != 0) {
            f32x4 g4[4], b4[4];
#pragma unroll
            for (int j = 0; j < 4; ++j) { g4[j] = *(const f32x4*)(lg + co + 256 * j); b4[j] = *(const f32x4*)(lb + co + 256 * j); }
            float s1[R], s2[R];
#pragma unroll
            for (int r = 0; r < R; ++r) { float a = 0.f, q = 0.f;
#pragma unroll
                for (int j = 0; j < 4; ++j) { a += (v[r][j][0] + v[r][j][1]) + (v[r][j][2] + v[r][j][3]); q += (v[r][j][0] * v[r][j][0] + v[r][j][1] * v[r][j][1]) + (v[r][j][2] * v[r][j][2] + v[r][j][3] * v[r][j][3]); }
                s1[r] = a; s2[r] = q; }
#pragma unroll
            for (int r = 0; r < R; ++r) { s1[r] = wave_sum(s1[r]); s2[r] = wave_sum(s2[r]); }
#pragma unroll
            for (int r = 0; r < R; ++r) { const float mean = s1[r] * (1.0f / D); const float var = fmaxf(s2[r] * (1.0f / D) - mean * mean, 0.f); const float rstd = 1.0f / sqrtf(var + LN_EPS);
#pragma unroll
                for (int j = 0; j < 4; ++j) v[r][j] = (v[r][j] - mean) * rstd * g4[j] + b4[j]; }
        }
        if (MODE == 2 && l == DEPTH - 1) {
#pragma unroll
            for (int r = 0; r < R; ++r) { float* dst = F.out + (size_t)(row0 + r) * D;
#pragma unroll
                for (int j = 0; j < 4; ++j) if (!dry) *(f32x4*)(dst + co + 256 * j) = v[r][j]; }
            continue;
        }
        const float* sh = mods_ptr(F, lm, bb, si); const float* scl = mods_ptr(F, lm, bb, si + 1);
        f32x4 sh4[4], sc4[4];
#pragma unroll
        for (int j = 0; j < 4; ++j) { sh4[j] = *(const f32x4*)(sh + co + 256 * j); sc4[j] = *(const f32x4*)(scl + co + 256 * j) + 1.0f; }
#pragma unroll
        for (int r = 0; r < R; ++r) { float* dst = xs_row(F, row0 + r);
#pragma unroll
            for (int j = 0; j < 4; ++j) { if (!dry && MODE != 0) __builtin_nontemporal_store(v[r][j] * DN_ALPHA, (f32x4*)(dst + co + 256 * j)); v[r][j] = v[r][j] * sc4[j] + sh4[j];
                u32x2 w; w.x = cvtpk(v[r][j][0], v[r][j][1]); w.y = cvtpk(v[r][j][2], v[r][j][3]); *(u32x2*)(ACT + (size_t)(row0 + r) * D + co + 256 * j) = w; } }
        if (MODE == 1 && moe) {
            const int jl = l >> 1; const float* rw = F.in[I_RW] + (size_t)jl * D * NE;
            float lg8[R][NE];
#pragma unroll
            for (int r = 0; r < R; ++r)
#pragma unroll
                for (int e = 0; e < NE; ++e) lg8[r][e] = 0.f;
#pragma unroll
            for (int j = 0; j < 4; ++j)
#pragma unroll
                for (int i = 0; i < 4; ++i) { const int k = co + 256 * j + i; const f32x4 w0 = *(const f32x4*)(rw + (size_t)k * NE), w1 = *(const f32x4*)(rw + (size_t)k * NE + 4);
#pragma unroll
                    for (int r = 0; r < R; ++r) { const float hv = v[r][j][i];
                        lg8[r][0] += hv * w0[0]; lg8[r][1] += hv * w0[1]; lg8[r][2] += hv * w0[2]; lg8[r][3] += hv * w0[3]; lg8[r][4] += hv * w1[0]; lg8[r][5] += hv * w1[1]; lg8[r][6] += hv * w1[2]; lg8[r][7] += hv * w1[3]; } }
#pragma unroll
            for (int r = 0; r < R; ++r)
#pragma unroll
                for (int e = 0; e < NE; ++e) lg8[r][e] = wave_sum(lg8[r][e]) + F.in[I_RB][jl * NE + e];
#pragma unroll
            for (int r = 0; r < R; ++r) {
                int e0 = 0; float l0 = lg8[r][0];
#pragma unroll
                for (int e = 1; e < NE; ++e) if (lg8[r][e] > l0) { l0 = lg8[r][e]; e0 = e; }
                int e1 = -1; float l1 = -3.0e38f;
#pragma unroll
                for (int e = 0; e < NE; ++e) if (e != e0 && lg8[r][e] > l1) { l1 = lg8[r][e]; e1 = e; }
                const float g0 = 1.0f / (1.0f + __expf(l1 - l0));
                if (!dry && F.lane == 2 * r) { ((unsigned*)(F.ws + WS_TOPE))[row0 + r] = (unsigned)e0 | ((unsigned)e1 << 8); ((f32x2*)(F.ws + WS_TOPG))[row0 + r] = (f32x2){g0, 1.0f - g0}; atomicAdd(F.ctl + CW_CNT + 64 * jl + e0, 1u); }
                if (!dry && F.lane == 2 * r + 1) atomicAdd(F.ctl + CW_CNT + 64 * jl + e1, 1u);
            }
        }
    }
}

__device__ __forceinline__ void ph_moe_gather(const Frame& F0, int l) {
    const Frame F = fresh(F0);
    constexpr int R = 4;
    const int jl = l >> 1, nrows = l < DEPTH - 1 ? M : BT;
    int mybase = 0; { int t = 0;
#pragma unroll
        for (int e = 0; e < NE; ++e) { mybase = (F.lane == e) ? t : mybase; t += (int)(((__hip_atomic_load(F.ctl + CW_CNT + 64 * jl + e, __ATOMIC_RELAXED, __HIP_MEMORY_SCOPE_AGENT) + 255u) >> 8) << 8); } }
    int* TOK = (int*)(F.ws + WS_TOK);
    if (F.bid == 0) {
        for (int e = 0; e < NE; ++e) { const int cnt = (int)__hip_atomic_load(F.ctl + CW_CNT + 64 * jl + e, __ATOMIC_RELAXED, __HIP_MEMORY_SCOPE_AGENT), base = __shfl(mybase, e);
            for (int p = cnt + F.tid; p < ((cnt + 255) & ~255); p += NTHR) TOK[base + p] = 0; } }
    for (int grp = F.bid * NWAVES + F.wave; grp < nrows / R; grp += F.G * NWAVES) {
        const int row0 = grp * R;
        int slot = 0;
        { const unsigned te = ((const unsigned*)(F.ws + WS_TOPE))[row0 + ((F.lane >> 1) & (R - 1))]; const int e = ((F.lane & 1) ? (te >> 8) : te) & 7;
          const int bsel = __shfl(mybase, e);
          if (F.lane < 2 * R) slot = bsel + (int)atomicAdd(F.ctl + CW_CUR + 64 * jl + e, 1u); }
#pragma unroll
        for (int r = 0; r < R; ++r) { const int s0 = __shfl(slot, 2 * r), s1 = __shfl(slot, 2 * r + 1);
            if (F.lane == 0) { ((int2*)(F.ws + WS_SLOT))[row0 + r] = make_int2(s0, s1); TOK[s0] = row0 + r; TOK[s1] = row0 + r; } }
    }
}

constexpr int ATT_TILEB = 32768, NT_LAT = (CT + T) / 64, NT_CTX = CT / 64;
constexpr float QSCALE = 0.125f * LOG2E;
__device__ __forceinline__ float fast_tanh(float x) { const float e = __builtin_amdgcn_exp2f(2.0f * LOG2E * x); return 1.0f - 2.0f * __builtin_amdgcn_rcpf(e + 1.0f); }
__device__ __forceinline__ void ph_prep1(const Frame& F0, int l, bool writeq) {
    const Frame F = fresh(F0);
    bf16_t* QKV = (bf16_t*)(F.ws + WS_QKV);
    unsigned char* KV = F.ws + WS_KV;
    {
        LAS f32x2* ROPE = (LAS f32x2*)F.lds;
        LAS bf16_t* VS = (LAS bf16_t*)(F.lds + 8192);
        for (int i = F.tid; i < 1024; i += NTHR) { const int pos = i >> 4, j = i & 15; const float ang = (float)pos * exp2f(-(float)j * (13.287712379549449f / 16.0f)); ROPE[i] = (f32x2){__cosf(ang), __sinf(ang)}; }
        const int tok = F.tid >> 5, sub = F.tid & 31, hm = sub >> 2, ax = (sub >> 1) & 1, chunk = sub & 1;
        struct P1In { u32x4 v0, v1, qa, qb, ka, kb; };
        auto p1load = [&](int u, P1In& x) { const int row0 = u * 16; const bf16_t* px = QKV + (size_t)(row0 + tok) * LDQ + hm * 64 + ax * 32 + chunk * 8;
            x.v0 = __builtin_nontemporal_load((const u32x4*)(QKV + (size_t)(row0 + (F.tid >> 6)) * LDQ + OV + 8 * (F.tid & 63))); x.v1 = __builtin_nontemporal_load((const u32x4*)(QKV + (size_t)(row0 + 8 + (F.tid >> 6)) * LDQ + OV + 8 * (F.tid & 63)));
            x.qa = __builtin_nontemporal_load((const u32x4*)(px + OQ)); x.qb = __builtin_nontemporal_load((const u32x4*)(px + OQ + 16)); x.ka = __builtin_nontemporal_load((const u32x4*)(px + OK_)); x.kb = __builtin_nontemporal_load((const u32x4*)(px + OK_ + 16)); };
        P1In cur, nxt;
        if (F.bid < M / 16) p1load(F.bid, cur);
        for (int u = F.bid; u < M / 16; u += F.G) {
            const int row0 = u * 16; const bool lat = row0 < BT; const int t0 = lat ? (row0 % T) : ((row0 - BT) % CT);
            const int b = lat ? row0 / T : (row0 - BT) / CT, kb = lat ? CT + t0 : t0, tile = kb >> 6, jq = (kb >> 4) & 3;
            if (u + F.G < M / 16) p1load(u + F.G, nxt);
            __syncthreads();
            const int row = row0 + tok, t = t0 + tok, pos = ax == 0 ? t / GW : t % GW;
            bf16_t* px = QKV + (size_t)row * LDQ;
            *(LAS u32x4*)(VS + (F.tid >> 6) * 512 + 8 * (F.tid & 63)) = cur.v0; *(LAS u32x4*)(VS + (8 + (F.tid >> 6)) * 512 + 8 * (F.tid & 63)) = cur.v1;
            f32x2 cs[8];
#pragma unroll
            for (int e = 0; e < 8; ++e) cs[e] = lat ? ROPE[pos * 16 + chunk * 8 + e] : (f32x2){1.0f, 0.f};
#pragma unroll
            for (int w = 0; w < 2; ++w) {
                bf16_t* p1 = px + (w ? OK_ : OQ) + hm * 64 + ax * 32 + chunk * 8; const u32x4 a = w ? cur.ka : cur.qa, bq = w ? cur.kb : cur.qb;
                u32x4 o1, o2; const float sc = w ? 1.0f : QSCALE;
#pragma unroll
                for (int e = 0; e < 4; ++e) { const float x1l = bflo(a[e]), x1h = bfhi(a[e]), x2l = bflo(bq[e]), x2h = bfhi(bq[e]); const f32x2 c0 = cs[2 * e], c1 = cs[2 * e + 1];
                    o1[e] = cvtpk((x1l * c0.x - x2l * c0.y) * sc, (x1h * c1.x - x2h * c1.y) * sc); o2[e] = cvtpk((x2l * c0.x + x1l * c0.y) * sc, (x2h * c1.x + x1h * c1.y) * sc); }
                if (w == 0) { if (writeq) { *(u32x4*)p1 = o1; *(u32x4*)(p1 + 16) = o2; } }
                else { unsigned char* timg = KV + ((size_t)(b * 4 + (hm >> 1)) * NT_LAT + tile) * ATT_TILEB + (hm & 1) * 8192 + (jq * 16 + tok) * 16;
                    *(u32x4*)(timg + ((ax * 2 + 0) * 2 + chunk) * 1024) = o1; *(u32x4*)(timg + ((ax * 2 + 1) * 2 + chunk) * 1024) = o2; }
            }
            __syncthreads();
#pragma unroll
            for (int pi = 0; pi < 2; ++pi) { const int p = F.tid + pi * NTHR, hh = p >> 8, dl = p & 31, kg = (p >> 5) & 1, dt = (p >> 6) & 3;
                const LAS bf16_t* vs = VS + hh * 128 + 32 * dt + dl + (4 * kg) * 512;
                u32x4 w; w.x = (unsigned)vs[0 * 512] | ((unsigned)vs[1 * 512] << 16); w.y = (unsigned)vs[2 * 512] | ((unsigned)vs[3 * 512] << 16);
                w.z = (unsigned)vs[8 * 512] | ((unsigned)vs[9 * 512] << 16); w.w = (unsigned)vs[10 * 512] | ((unsigned)vs[11 * 512] << 16);
                *(u32x4*)(KV + ((size_t)(b * 4 + hh) * NT_LAT + tile) * ATT_TILEB + 16384 + (((dt * 4 + jq) * 2 + kg) * 32 + dl) * 16) = w; }
            cur = nxt;
        }
    }
}
__device__ __forceinline__ void ph_prep2(const Frame& F0, int l) {
    const Frame F = fresh(F0);
    const bf16_t* REST = (const bf16_t*)(F.ws + WS_REST); bf16_t* MIX = (bf16_t*)(F.ws + WS_ACT);
    {
        const float* cw = F.in[I_CONVW] + (size_t)l * 3 * 256;
        const int tok = F.tid >> 5, c8 = (F.tid & 31) * 8;
        f32x4 w3[3][2];
#pragma unroll
        for (int j = 0; j < 3; ++j) { w3[j][0] = *(const f32x4*)(cw + j * 256 + c8); w3[j][1] = *(const f32x4*)(cw + j * 256 + c8 + 4); }
        struct P2In { u32x4 hc, cc, cb, hmv, cmv, hpv, cpv; };
        auto p2load = [&](int u, P2In& x) {
            const int row0 = u * 16; const bool lat = row0 < BT; const int tseq = lat ? T : CT, t = (lat ? (row0 % T) : ((row0 - BT) % CT)) + tok, row = row0 + tok;
            const bf16_t* pc = REST + (size_t)row * LDR; const bool hm_ = t > 0, hp_ = t + 1 < tseq; const bf16_t* pm = hm_ ? pc - LDR : pc; const bf16_t* pp = hp_ ? pc + LDR : pc;
            const unsigned mkm = hm_ ? 0xffffffffu : 0u, mkp = hp_ ? 0xffffffffu : 0u;
            x.hc = __builtin_nontemporal_load((const u32x4*)(pc + OCH + c8)); x.cc = __builtin_nontemporal_load((const u32x4*)(pc + OCC + c8)); x.cb = __builtin_nontemporal_load((const u32x4*)(pc + OCB + c8));
            x.hmv = *(const u32x4*)(pm + OCH + c8) & mkm; x.cmv = *(const u32x4*)(pm + OCC + c8); x.hpv = *(const u32x4*)(pp + OCH + c8) & mkp; x.cpv = *(const u32x4*)(pp + OCC + c8); };
        P2In cur, nxt;
        if (F.bid < M / 16) p2load(F.bid, cur);
        for (int u = F.bid; u < M / 16; u += F.G) {
            if (u + F.G < M / 16) p2load(u + F.G, nxt);
            const int row = u * 16 + tok;
            u32x4 o;
#pragma unroll
            for (int e = 0; e < 4; ++e) {
                const float lo = bflo(cur.cb[e]) * (w3[0][e >> 1][2 * (e & 1)] * bflo(cur.hmv[e]) * bflo(cur.cmv[e]) + w3[1][e >> 1][2 * (e & 1)] * bflo(cur.hc[e]) * bflo(cur.cc[e]) + w3[2][e >> 1][2 * (e & 1)] * bflo(cur.hpv[e]) * bflo(cur.cpv[e]));
                const float hi = bfhi(cur.cb[e]) * (w3[0][e >> 1][2 * (e & 1) + 1] * bfhi(cur.hmv[e]) * bfhi(cur.cmv[e]) + w3[1][e >> 1][2 * (e & 1) + 1] * bfhi(cur.hc[e]) * bfhi(cur.cc[e]) + w3[2][e >> 1][2 * (e & 1) + 1] * bfhi(cur.hpv[e]) * bfhi(cur.cpv[e]));
                o[e] = cvtpk(lo, hi); }
            __builtin_nontemporal_store(o, (u32x4*)(MIX + (size_t)row * D + 768 + c8));
            cur = nxt;
        }
    }
}
constexpr int NCH = (CT + T) / 16, CH_REC = 12544, CH_AF = 0, CH_RF = 2048, CH_BKF = 4096, CH_MRF = 8192, CH_TF = 9216, CH_MAF = 9728, CH_GC = 10240, CH_VF = 10496;
constexpr int F3_ROWS = 0, F3_LM = 73728, F3_VROW = 106496, F3_GCL = 114688, F3_XCH = 116736, F3_CWT = 117760, F3_PRM = 126976, F3_ACTS = 134144;
#define WLDS_FENCE() asm volatile("s_waitcnt lgkmcnt(0)" ::: "memory")
#define DPPF(v, ctrl, fill) __builtin_bit_cast(float, __builtin_amdgcn_update_dpp(__builtin_bit_cast(int, (float)(fill)), __builtin_bit_cast(int, (v)), (ctrl), 0xf, 0xf, false))
__device__ __forceinline__ void ph_prep3f(const Frame& F0, int l) {
    const Frame F = fresh(F0);
    const bf16_t* REST = (const bf16_t*)(F.ws + WS_REST);
    bf16_t* RW = (bf16_t*)(F.ws + WS_R2);
    LAS float* CWT = (LAS float*)(F.lds + F3_CWT);
    LAS float* PRM = (LAS float*)(F.lds + F3_PRM);
    LAS bf16_t* ACTS = (LAS bf16_t*)(F.lds + F3_ACTS);
    LAS bf16_t* VROW = (LAS bf16_t*)(F.lds + F3_VROW);
    LAS float* GCL = (LAS float*)(F.lds + F3_GCL);
    LAS f32x2* XCH = (LAS f32x2*)(F.lds + F3_XCH);
    __syncthreads();
    {   const int ti = F.tid; f32x4 cwa, cwb = (f32x4){0.f, 0.f, 0.f, 0.f}, pr = cwb;
        cwa = *(const f32x4*)(F.in[I_RKVCONV] + (size_t)l * 3 * 768 + 4 * ti);
        if (ti < 64) cwb = *(const f32x4*)(F.in[I_RKVCONV] + (size_t)l * 3 * 768 + 2048 + 4 * ti);
        if (ti < 448) { const float* src = ti < 128 ? F.in[I_DW0] + l * 512 + 4 * ti : (ti < 256 ? F.in[I_A0] + l * 512 + 4 * (ti - 128) : (ti < 320 ? F.in[I_KK] + l * 256 + 4 * (ti - 256) : (ti < 384 ? F.in[I_KA] + l * 256 + 4 * (ti - 320) : F.in[I_RK] + l * 256 + 4 * (ti - 384))));
            pr = *(const f32x4*)src; }
        *(LAS f32x4*)(CWT + 4 * ti) = cwa; if (ti < 64) *(LAS f32x4*)(CWT + 2048 + 4 * ti) = cwb; if (ti < 448) *(LAS f32x4*)(PRM + 4 * ti) = pr;
    }
    const int h = F.wave >> 1, p = F.wave & 1;
    LAS bf16_t* rowsd = (LAS bf16_t*)(F.lds + F3_ROWS);
    LAS float* LM = (LAS float*)(F.lds + F3_LM + F.wave * 4096);
    LAS float* LT = LM;
    for (int u = F.bid; u < M / 16; u += F.G) {
        const int row0 = u * 16; const bool lat = row0 < BT; const int tseq = lat ? T : CT, t0 = lat ? (row0 % T) : ((row0 - BT) % CT);
        const int b = lat ? row0 / T : (row0 - BT) / CT, pc = lat ? CT / 16 + t0 / 16 : t0 / 16;
        int tl1 = F.tid; asm volatile("" : "+v"(tl1));
        const int lane = tl1 & 63, n = lane & 15, g = lane >> 4;
        const int row = row0 + n, t = t0 + n; const bool hm_ = t > 0, hp_ = t + 1 < tseq;
        if (tl1 < 384) { const int tk = tl1 / 24, gi = tl1 % 24;
            const u32x4 x = __builtin_nontemporal_load((const u32x4*)(REST + (size_t)(row0 + tk) * LDR + OWD + gi * 8)); u32x4 o;
#pragma unroll
            for (int e = 0; e < 4; ++e) { float lo = bflo(x[e]), hi = bfhi(x[e]);
                if (gi < 8) { lo = fast_tanh(lo); hi = fast_tanh(hi); } else if (gi >= 16) { lo = sigmoidf_(lo); hi = sigmoidf_(hi); }
                o[e] = cvtpk(lo, hi); }
            *(LAS u32x4*)(ACTS + tk * 200 + gi * 8) = o; }
        bf16x8 af[2][6];
#pragma unroll
        for (int c2 = 0; c2 < 2; ++c2)
#pragma unroll
            for (int w = 0; w < 6; ++w) af[c2][w] = *(const bf16x8*)(F.ws + WS_LW + ((size_t)((w * 16 + h * 4 + 2 * p + c2) * 64 + lane)) * 16);
        struct R9 { u32x2 r0, r1, r2, k0, k1, k2, v0, v1, v2; } r9[2];
        const unsigned mkm = hm_ ? 0xffffffffu : 0u, mkp = hp_ ? 0xffffffffu : 0u;
#pragma unroll
        for (int c2 = 0; c2 < 2; ++c2) { const bf16_t* pcn = REST + (size_t)row * LDR + h * 64 + (2 * p + c2) * 16 + 4 * g;
            const bf16_t* pm = hm_ ? pcn - LDR : pcn; const bf16_t* pp = hp_ ? pcn + LDR : pcn;
            r9[c2].r1 = *(const u32x2*)(pcn + ORR); r9[c2].k1 = *(const u32x2*)(pcn + ORK); r9[c2].v1 = *(const u32x2*)(pcn + ORV);
            r9[c2].r0 = *(const u32x2*)(pm + ORR); r9[c2].k0 = *(const u32x2*)(pm + ORK); r9[c2].v0 = *(const u32x2*)(pm + ORV);
            r9[c2].r2 = *(const u32x2*)(pp + ORR); r9[c2].k2 = *(const u32x2*)(pp + ORK); r9[c2].v2 = *(const u32x2*)(pp + ORV); }
        __syncthreads();
        float ss = 0.f, bon = 0.f;
        {
            bf16x8 bf[6];
#pragma unroll
            for (int w = 0; w < 6; ++w) bf[w] = *(const LAS bf16x8*)(ACTS + n * 200 + w * 32 + 8 * g);
            const f32x4 z4 = (f32x4){0.f, 0.f, 0.f, 0.f};
#define CONV4(dst, a0_, a1_, a2_, off) { const f32x4 w0_ = *(const LAS f32x4*)(CWT + 0 * 768 + (off) + c0), w1_ = *(const LAS f32x4*)(CWT + 1 * 768 + (off) + c0), w2_ = *(const LAS f32x4*)(CWT + 2 * 768 + (off) + c0); \
                dst = (f32x4){w0_[0] * bflo(a0_.x) + w1_[0] * bflo(a1_.x) + w2_[0] * bflo(a2_.x), w0_[1] * bfhi(a0_.x) + w1_[1] * bfhi(a1_.x) + w2_[1] * bfhi(a2_.x), \
                              w0_[2] * bflo(a0_.y) + w1_[2] * bflo(a1_.y) + w2_[2] * bflo(a2_.y), w0_[3] * bfhi(a0_.y) + w1_[3] * bfhi(a1_.y) + w2_[3] * bfhi(a2_.y)}; }
#define PK4(x_) (u32x2){cvtpk((x_)[0], (x_)[1]), cvtpk((x_)[2], (x_)[3])}
#pragma unroll
            for (int c2 = 0; c2 < 2; ++c2) { const int ct = 2 * p + c2, c0 = h * 64 + ct * 16 + 4 * g, cl = ct * 16 + 4 * g;
                const f32x4 aW0c = __builtin_amdgcn_mfma_f32_16x16x32_bf16(af[c2][0], bf[0], z4, 0, 0, 0), aW1c = __builtin_amdgcn_mfma_f32_16x16x32_bf16(af[c2][1], bf[1], z4, 0, 0, 0);
                const f32x4 aA0c = __builtin_amdgcn_mfma_f32_16x16x32_bf16(af[c2][2], bf[2], z4, 0, 0, 0), aA1c = __builtin_amdgcn_mfma_f32_16x16x32_bf16(af[c2][3], bf[3], z4, 0, 0, 0);
                f32x4 aGc = __builtin_amdgcn_mfma_f32_16x16x32_bf16(af[c2][4], bf[4], z4, 0, 0, 0); aGc = __builtin_amdgcn_mfma_f32_16x16x32_bf16(af[c2][5], bf[5], aGc, 0, 0, 0);
                R9& q = r9[c2];
                q.r0.x &= mkm; q.r0.y &= mkm; q.k0.x &= mkm; q.k0.y &= mkm; q.v0.x &= mkm; q.v0.y &= mkm; q.r2.x &= mkp; q.r2.y &= mkp; q.k2.x &= mkp; q.k2.y &= mkp; q.v2.x &= mkp; q.v2.y &= mkp;
                f32x4 rc, kc, vc;
                CONV4(rc, q.r0, q.r1, q.r2, 0) CONV4(kc, q.k0, q.k1, q.k2, 256) CONV4(vc, q.v0, q.v1, q.v2, 512)
                const f32x4 w00 = *(const LAS f32x4*)(PRM + c0), w01 = *(const LAS f32x4*)(PRM + 256 + c0), a00 = *(const LAS f32x4*)(PRM + 512 + c0), a01 = *(const LAS f32x4*)(PRM + 768 + c0);
                const f32x4 kkw = *(const LAS f32x4*)(PRM + 1024 + c0), kaw = *(const LAS f32x4*)(PRM + 1280 + c0), rkw = *(const LAS f32x4*)(PRM + 1536 + c0);
                f32x4 dec0, dec1, ia0, ia1;
#pragma unroll
                for (int e = 0; e < 4; ++e) { dec0[e] = __expf(-0.6065306597126334f * sigmoidf_(w00[e] + aW0c[e])); dec1[e] = __expf(-0.6065306597126334f * sigmoidf_(w01[e] + aW1c[e]));
                    ia0[e] = sigmoidf_(a00[e] + aA0c[e]); ia1[e] = sigmoidf_(a01[e] + aA1c[e]); }
                const f32x4 kd0 = kc * (1.0f + (ia0 - 1.0f) * kaw), kd1 = kc * (1.0f + (ia1 - 1.0f) * kaw), kr = kc * kkw;
                { const f32x4 bq = rc * (kd0 + kd1) * rkw; bon += (bq[0] + bq[1]) + (bq[2] + bq[3]); }
                ss += (kr[0] * kr[0] + kr[1] * kr[1]) + (kr[2] * kr[2] + kr[3] * kr[3]);
                const size_t o = (size_t)row * 256 + c0; const u32x2 vpk = (u32x2){cvtpk(vc[0], vc[1]), cvtpk(vc[2], vc[3])};
                *(u32x2*)(RW + (size_t)RW_V * (RWSZ / 2) + o) = vpk; *(u32x2*)(RW + (size_t)RW_G * (RWSZ / 2) + o) = (u32x2){cvtpk(aGc[0], aGc[1]), cvtpk(aGc[2], aGc[3])};
                *(LAS u32x2*)(VROW + (h * 16 + n) * 64 + cl) = vpk;
                float A0[4], R0[4], B0[4], K0[4], A1[4], R1[4], B1[4], K1[4];
#pragma unroll
                for (int e = 0; e < 4; ++e) {
                    float gs = dec0[e];
                    gs *= DPPF(gs, 0x111, 1.0f); gs *= DPPF(gs, 0x112, 1.0f); gs *= DPPF(gs, 0x114, 1.0f); gs *= DPPF(gs, 0x118, 1.0f);
                    { const float gm1 = DPPF(gs, 0x111, 1.0f), ig = __builtin_amdgcn_rcpf(gs);
                      A0[e] = -kr[e] * gm1; R0[e] = rc[e] * gs; B0[e] = kr[e] * ia0[e] * ig; K0[e] = kd0[e] * ig;
                      if (n == 15) GCL[(h * 2 + 0) * 64 + cl + e] = gs; }
                    float gr = dec1[e];
                    gr *= DPPF(gr, 0x101, 1.0f); gr *= DPPF(gr, 0x102, 1.0f); gr *= DPPF(gr, 0x104, 1.0f); gr *= DPPF(gr, 0x108, 1.0f);
                    { const float gm1 = DPPF(gr, 0x101, 1.0f), ig = __builtin_amdgcn_rcpf(gr);
                      A1[e] = -kr[e] * gm1; R1[e] = rc[e] * gr; B1[e] = kr[e] * ia1[e] * ig; K1[e] = kd1[e] * ig;
                      if (n == 0) GCL[(h * 2 + 1) * 64 + cl + e] = gr; } }
                LAS bf16_t* r0p = rowsd + ((h * 2 + 0) * 4) * 1152 + n * 72 + cl; LAS bf16_t* r1p = rowsd + ((h * 2 + 1) * 4) * 1152 + (15 - n) * 72 + cl;
                *(LAS u32x2*)(r0p) = PK4(A0); *(LAS u32x2*)(r0p + 1152) = PK4(R0); *(LAS u32x2*)(r0p + 2304) = PK4(B0); *(LAS u32x2*)(r0p + 3456) = PK4(K0);
                *(LAS u32x2*)(r1p) = PK4(A1); *(LAS u32x2*)(r1p + 1152) = PK4(R1); *(LAS u32x2*)(r1p + 2304) = PK4(B1); *(LAS u32x2*)(r1p + 3456) = PK4(K1); }
#undef CONV4
#undef PK4
        }
        ss += __shfl_xor(ss, 16); ss += __shfl_xor(ss, 32); bon += __shfl_xor(bon, 16); bon += __shfl_xor(bon, 32);
        if (g == 0) XCH[(h * 2 + p) * 16 + n] = (f32x2){ss, bon};
        __syncthreads();
        {
            int tl3 = F.tid; asm volatile("" : "+v"(tl3));
            const int lane = tl3 & 63, t_ = lane & 15, g_ = lane >> 4;
            const int dir = p, chain = dir * 32 + b * 4 + h;
            const int cc = pc < CT / 16 ? (dir ? CT / 16 - 1 - pc : pc) : CT / 16 + (dir ? T / 16 - 1 - (pc - CT / 16) : pc - CT / 16);
            unsigned char* rec = F.ws + ch_off_c(chain) + (size_t)cc * CH_REC;
            LAS bf16_t* LAh = rowsd + ((h * 2 + dir) * 4) * 1152; LAS bf16_t* LRh = LAh + 1152; LAS bf16_t* LBh = LRh + 1152; LAS bf16_t* LKh = LBh + 1152;
            const LAS float* gcl = GCL + (h * 2 + dir) * 64;
            ((float*)(rec + CH_GC))[lane] = gcl[lane];
            {
                const int pos = dir ? 15 - t_ : t_; const f32x2 xa = XCH[(h * 2 + 0) * 16 + pos], xb = XCH[(h * 2 + 1) * 16 + pos];
                const float inorm = __builtin_amdgcn_rsqf(fmaxf(xa.x + xb.x, 1e-24f));
                if (dir == 0 && g_ == 0) ((float*)(F.ws + WS_BONUS))[(size_t)(row0 + t_) * 4 + h] = xa.y + xb.y;
#pragma unroll
                for (int q = 0; q < 2; ++q) { LAS u32x4* pa = (LAS u32x4*)(LAh + t_ * 72 + 16 * g_ + 8 * q); LAS u32x4* pb = (LAS u32x4*)(LBh + t_ * 72 + 16 * g_ + 8 * q); const u32x4 va = *pa, vb = *pb; u32x4 oa, ob;
#pragma unroll
                    for (int e = 0; e < 4; ++e) { oa[e] = cvtpk(bflo(va[e]) * inorm, bfhi(va[e]) * inorm); ob[e] = cvtpk(bflo(vb[e]) * inorm, bfhi(vb[e]) * inorm); }
                    *pa = oa; *pb = ob; }
                WLDS_FENCE();
            }
#pragma unroll
            for (int s2 = 0; s2 < 2; ++s2) {
                const u32x2 a0 = *(const LAS u32x2*)(LAh + t_ * 72 + 32 * s2 + 4 * g_), a1 = *(const LAS u32x2*)(LAh + t_ * 72 + 32 * s2 + 16 + 4 * g_);
                *(u32x4*)(rec + CH_AF + s2 * 1024 + lane * 16) = (u32x4){a0.x, a0.y, a1.x, a1.y};
                const u32x2 q0 = *(const LAS u32x2*)(LRh + t_ * 72 + 32 * s2 + 4 * g_), q1 = *(const LAS u32x2*)(LRh + t_ * 72 + 32 * s2 + 16 + 4 * g_);
                *(u32x4*)(rec + CH_RF + s2 * 1024 + lane * 16) = (u32x4){q0.x, q0.y, q1.x, q1.y}; }
            f32x4 mab = (f32x4){0.f, 0.f, 0.f, 0.f}, mak = mab, mrb = mab, mrk = mab;
#pragma unroll
            for (int s2 = 0; s2 < 2; ++s2) {
                const bf16x8 fa = *(const LAS bf16x8*)(LAh + t_ * 72 + 32 * s2 + 8 * g_), fr = *(const LAS bf16x8*)(LRh + t_ * 72 + 32 * s2 + 8 * g_);
                const bf16x8 fb = *(const LAS bf16x8*)(LBh + t_ * 72 + 32 * s2 + 8 * g_), fk = *(const LAS bf16x8*)(LKh + t_ * 72 + 32 * s2 + 8 * g_);
                mab = __builtin_amdgcn_mfma_f32_16x16x32_bf16(fa, fb, mab, 0, 0, 0); mak = __builtin_amdgcn_mfma_f32_16x16x32_bf16(fa, fk, mak, 0, 0, 0);
                mrb = __builtin_amdgcn_mfma_f32_16x16x32_bf16(fr, fb, mrb, 0, 0, 0); mrk = __builtin_amdgcn_mfma_f32_16x16x32_bf16(fr, fk, mrk, 0, 0, 0); }
            WLDS_FENCE();
#pragma unroll
            for (int r = 0; r < 4; ++r) { const int tt = 4 * g_ + r, i = t_;
                LM[0 * 256 + tt * 16 + i] = i < tt ? mab[r] : 0.f; LM[1 * 256 + tt * 16 + i] = i < tt ? mak[r] : 0.f;
                LM[2 * 256 + tt * 16 + i] = i <= tt ? mrb[r] : 0.f; LM[3 * 256 + tt * 16 + i] = i <= tt ? mrk[r] : 0.f; }
            WLDS_FENCE();
            { float Tc[16];
#pragma unroll
              for (int tt = 0; tt < 16; ++tt) { float acc = (tt == t_) ? 1.0f : 0.f;
#pragma unroll
                  for (int i = 0; i < tt; ++i) acc += LM[tt * 16 + i] * Tc[i];
                  Tc[tt] = acc; }
              WLDS_FENCE();
              if (g_ == 0) {
#pragma unroll
                  for (int tt = 0; tt < 16; ++tt) LT[tt * 16 + t_] = Tc[tt]; } }
            WLDS_FENCE();
            const f32x4 zz = (f32x4){0.f, 0.f, 0.f, 0.f};
            const u32x2 ttf = (u32x2){cvtpk(LT[(4 * g_ + 0) * 16 + t_], LT[(4 * g_ + 1) * 16 + t_]), cvtpk(LT[(4 * g_ + 2) * 16 + t_], LT[(4 * g_ + 3) * 16 + t_])};
            { const f32x4 ak4 = *(const LAS f32x4*)(LM + 256 + t_ * 16 + 4 * g_), rb4 = *(const LAS f32x4*)(LM + 512 + t_ * 16 + 4 * g_), rk4 = *(const LAS f32x4*)(LM + 768 + t_ * 16 + 4 * g_);
              const f32x4 rbt = __builtin_amdgcn_mfma_f32_16x16x16bf16_1k(BF4(ttf), BF4(((u32x2){cvtpk(rb4[0], rb4[1]), cvtpk(rb4[2], rb4[3])})), zz, 0, 0, 0);
              *(u32x2*)(rec + CH_MAF + lane * 8) = (u32x2){cvtpk(ak4[0], ak4[1]), cvtpk(ak4[2], ak4[3])};
              *(u32x4*)(rec + CH_MRF + lane * 16) = (u32x4){cvtpk(rbt[0], rbt[1]), cvtpk(rbt[2], rbt[3]), cvtpk(rk4[0], rk4[1]), cvtpk(rk4[2], rk4[3])}; }
#pragma unroll
            for (int kt = 0; kt < 4; ++kt) { const LAS bf16_t* pb = LBh + (4 * g_) * 72 + 16 * kt + t_; const LAS bf16_t* pk = LKh + (4 * g_) * 72 + 16 * kt + t_; const float gck = gcl[16 * kt + t_];
                const u32x2 bcol = (u32x2){(unsigned)pb[0] | ((unsigned)pb[72] << 16), (unsigned)pb[144] | ((unsigned)pb[216] << 16)};
                const f32x4 bt = __builtin_amdgcn_mfma_f32_16x16x16bf16_1k(BF4(ttf), BF4(bcol), zz, 0, 0, 0);
                u32x4 w; w.x = cvtpk(bt[0] * gck, bt[1] * gck); w.y = cvtpk(bt[2] * gck, bt[3] * gck); w.z = cvtpk(bf2f(pk[0]) * gck, bf2f(pk[72]) * gck); w.w = cvtpk(bf2f(pk[144]) * gck, bf2f(pk[216]) * gck);
                *(u32x4*)(rec + CH_BKF + kt * 1024 + lane * 16) = w; }
#pragma unroll
            for (int vq = 0; vq < 4; ++vq) { unsigned short v4[4];
#pragma unroll
                for (int i = 0; i < 4; ++i) { const int tt = 4 * g_ + i; v4[i] = VROW[(h * 16 + (dir ? 15 - tt : tt)) * 64 + vq * 16 + t_]; }
                *(u32x2*)(rec + CH_VF + vq * 512 + lane * 8) = (u32x2){(unsigned)v4[0] | ((unsigned)v4[1] << 16), (unsigned)v4[2] | ((unsigned)v4[3] << 16)}; }
        }
    }
}
#undef DPPF
__device__ __forceinline__ void ph_prep(const Frame& F, int l, bool writeq = true) {
#ifndef DIS_P1
    if ((REP_MASK >> 13) & 1) ph_prep1(F, l, false);
    ph_prep1(F, l, writeq);
#endif
#ifndef DIS_P2
    if ((REP_MASK >> 14) & 1) ph_prep2(F, l);
    ph_prep2(F, l);
#endif
}

__device__ __forceinline__ int chain_rowbase(int dir, int b, int cc) { if (cc < CT / 16) { const int pc = dir ? CT / 16 - 1 - cc : cc; return BT + b * CT + pc * 16; } const int pc = dir ? T / 16 - 1 - (cc - CT / 16) : cc - CT / 16; return b * T + pc * 16; }
struct ScanOps { u32x4 af0, af1, rf0, rf1, bk0, bk1, bk2, bk3, mrf; u32x2 maf, vf; f32x4 gc0, gc1, gc2, gc3; };
__device__ __forceinline__ void scan_load(ScanOps& o, const LAS unsigned char* rec, int lane, int g_, int vq) {
    o.af0 = *(const LAS u32x4*)(rec + CH_AF + lane * 16); o.af1 = *(const LAS u32x4*)(rec + CH_AF + 1024 + lane * 16);
    o.rf0 = *(const LAS u32x4*)(rec + CH_RF + lane * 16); o.rf1 = *(const LAS u32x4*)(rec + CH_RF + 1024 + lane * 16);
    o.bk0 = *(const LAS u32x4*)(rec + CH_BKF + lane * 16); o.bk1 = *(const LAS u32x4*)(rec + CH_BKF + 1024 + lane * 16); o.bk2 = *(const LAS u32x4*)(rec + CH_BKF + 2048 + lane * 16); o.bk3 = *(const LAS u32x4*)(rec + CH_BKF + 3072 + lane * 16);
    o.mrf = *(const LAS u32x4*)(rec + CH_MRF + lane * 16); o.maf = *(const LAS u32x2*)(rec + CH_MAF + lane * 8); o.vf = *(const LAS u32x2*)(rec + CH_VF + vq * 512 + lane * 8);
    const LAS float* gc = (const LAS float*)(rec + CH_GC) + 4 * g_;
    o.gc0 = *(const LAS f32x4*)(gc); o.gc1 = *(const LAS f32x4*)(gc + 16); o.gc2 = *(const LAS f32x4*)(gc + 32); o.gc3 = *(const LAS f32x4*)(gc + 48);
}
#define BF8(v) __builtin_bit_cast(bf16x8, (v))
constexpr int SCAN_NS = 10;
#define SCAN_BAR() do { asm volatile("s_waitcnt lgkmcnt(0)" ::: "memory"); __builtin_amdgcn_s_barrier(); asm volatile("" ::: "memory"); } while (0)
template <int NI> __device__ __forceinline__ void scan_issue(LAS unsigned char* lds, const unsigned char* recs, int c, int wl, int lane) {
    const unsigned char* src = recs + (size_t)c * CH_REC; LAS unsigned char* dst = lds + (c % SCAN_NS) * CH_REC;
#pragma unroll
    for (int i = 0; i < 3; ++i) { const int chunk = i * 4 + wl; __builtin_amdgcn_global_load_lds((const unsigned*)(src + chunk * 1024 + lane * 16), (LAS unsigned*)(dst + chunk * 1024), 16, 0, 0); }
    if (NI == 4) { if (lane < 16) __builtin_amdgcn_global_load_lds((const unsigned*)(src + 12 * 1024 + lane * 16), (LAS unsigned*)(dst + 12 * 1024), 16, 0, 0); }
}
template <int NI> __device__ __forceinline__ void scan_loader(LAS unsigned char* lds, const unsigned char* recs, int wl, int lane) {
#pragma unroll
    for (int c = 0; c < SCAN_NS - 1; ++c) scan_issue<NI>(lds, recs, c, wl, lane);
    if (NI == 4) asm volatile("s_waitcnt vmcnt(32)" ::: "memory"); else asm volatile("s_waitcnt vmcnt(24)" ::: "memory");
    SCAN_BAR();
    for (int cc = 0; cc < NCH; ++cc) {
        if (cc + SCAN_NS - 2 < NCH) { if (NI == 4) asm volatile("s_waitcnt vmcnt(28)" ::: "memory"); else asm volatile("s_waitcnt vmcnt(21)" ::: "memory"); }
        else asm volatile("s_waitcnt vmcnt(0)" ::: "memory");
        SCAN_BAR();
        if (cc + SCAN_NS - 1 < NCH) scan_issue<NI>(lds, recs, cc + SCAN_NS - 1, wl, lane);
    }
}
__device__ __forceinline__ void ph_seqscan(const Frame& F0, int l) {
    const Frame F = fresh(F0);
    if (F.bid >= 64) return;
    const int chain = F.bid, lane = F.lane;
    const unsigned char* recs = F.ws + ch_off_c(chain);
    if (F.wave >= 4) { if (F.wave == 4) scan_loader<4>(F.lds, recs, 0, lane); else scan_loader<3>(F.lds, recs, F.wave - 4, lane); return; }
    const int vq = F.wave, v_ = lane & 15, g_ = lane >> 4, dir = chain >> 5, b = (chain >> 2) & 7, h = chain & 3;
    unsigned* YD2 = (unsigned*)(F.ws + WS_YD) + (size_t)dir * (M / 2) * 256 + h * 64 + vq * 16 + v_;
    float zf = 0.f; asm volatile("" : "+v"(zf));
    const f32x4 z4 = (f32x4){zf, zf, zf, zf};
    f32x4 st0 = z4, st1 = z4, st2 = z4, st3 = z4;
#define SCAN_STEP(cur, cc) do { \
        const u32x4 sb0 = (u32x4){cvtpk(st0[0], st0[1]), cvtpk(st0[2], st0[3]), cvtpk(st1[0], st1[1]), cvtpk(st1[2], st1[3])}; \
        const u32x4 sb1 = (u32x4){cvtpk(st2[0], st2[1]), cvtpk(st2[2], st2[3]), cvtpk(st3[0], st3[1]), cvtpk(st3[2], st3[3])}; \
        f32x4 x = __builtin_amdgcn_mfma_f32_16x16x16bf16_1k(BF4(cur.maf), BF4(cur.vf), z4, 0, 0, 0);     \
        x = __builtin_amdgcn_mfma_f32_16x16x32_bf16(BF8(cur.af0), BF8(sb0), x, 0, 0, 0); \
        x = __builtin_amdgcn_mfma_f32_16x16x32_bf16(BF8(cur.af1), BF8(sb1), x, 0, 0, 0); \
        const u32x4 uv = (u32x4){cvtpk(x[0], x[1]), cvtpk(x[2], x[3]), cur.vf.x, cur.vf.y};     \
        f32x4 y = __builtin_amdgcn_mfma_f32_16x16x32_bf16(BF8(cur.rf0), BF8(sb0), z4, 0, 0, 0); \
        y = __builtin_amdgcn_mfma_f32_16x16x32_bf16(BF8(cur.rf1), BF8(sb1), y, 0, 0, 0); \
        y = __builtin_amdgcn_mfma_f32_16x16x32_bf16(BF8(cur.mrf), BF8(uv), y, 0, 0, 0); \
        st0 = __builtin_amdgcn_mfma_f32_16x16x32_bf16(BF8(cur.bk0), BF8(uv), st0 * cur.gc0, 0, 0, 0); \
        st1 = __builtin_amdgcn_mfma_f32_16x16x32_bf16(BF8(cur.bk1), BF8(uv), st1 * cur.gc1, 0, 0, 0); \
        st2 = __builtin_amdgcn_mfma_f32_16x16x32_bf16(BF8(cur.bk2), BF8(uv), st2 * cur.gc2, 0, 0, 0); \
        st3 = __builtin_amdgcn_mfma_f32_16x16x32_bf16(BF8(cur.bk3), BF8(uv), st3 * cur.gc3, 0, 0, 0); \
          \
        if (dir) { yp[0] = cvtpk(y[1], y[0]); yp[-256] = cvtpk(y[3], y[2]); }        \
        else { yp[0] = cvtpk(y[0], y[1]); yp[256] = cvtpk(y[2], y[3]); } \
        yp += ystep; } while (0)
    ScanOps cur, nxt;
    SCAN_BAR();
    scan_load(cur, F.lds, lane, g_, vq);
    int slot = 0;
    const int ystep = dir ? -8 * 256 : 8 * 256;
#pragma unroll 1
    for (int seg = 0; seg < 2; ++seg) {
        const int nseg = seg ? T / 16 : CT / 16, rb0 = chain_rowbase(dir, b, seg ? CT / 16 : 0);
        unsigned* yp = YD2 + (size_t)((rb0 >> 1) + (dir ? 7 - 2 * g_ : 2 * g_)) * 256;
#pragma unroll 1
        for (int k = 0; k < nseg; k += 2) {
            SCAN_BAR();
            slot = slot + 1 == SCAN_NS ? 0 : slot + 1;
            scan_load(nxt, F.lds + slot * CH_REC, lane, g_, vq);
            SCAN_STEP(cur, 0);
            SCAN_BAR();
            if (seg == 0 || k + 2 < nseg) slot = slot + 1 == SCAN_NS ? 0 : slot + 1;
            scan_load(cur, F.lds + slot * CH_REC, lane, g_, vq);
            SCAN_STEP(nxt, 0);
        }
    }
#undef SCAN_STEP
}
static_assert(NCH % 2 == 0, "the scan's chunk loop is unrolled by two");

typedef float f32x16 __attribute__((ext_vector_type(16)));
#define ATT_WAITV(n) asm volatile("s_waitcnt vmcnt(" #n ")" ::: "memory")
#define ATT_BAR() do { asm volatile("s_waitcnt lgkmcnt(0)" ::: "memory"); __builtin_amdgcn_s_barrier(); asm volatile("" ::: "memory"); } while (0)
constexpr int ATT_KRING = 0, ATT_VRING = 49152, ATT_XCH = 98304;
__device__ __forceinline__ void att_issue_k(LAS unsigned char* lds, const unsigned char* img, int tile, int wave, int lane) {
#pragma unroll
    for (int i = 0; i < 2; ++i) { const int chunk = i * 8 + wave;
        __builtin_amdgcn_global_load_lds((const unsigned*)(img + (size_t)tile * ATT_TILEB + chunk * 1024 + lane * 16), (LAS unsigned*)(lds + ATT_KRING + (tile % 3) * 16384 + chunk * 1024), 16, 0, 0); }
}
__device__ __forceinline__ void att_issue_v(LAS unsigned char* lds, const unsigned char* img, int tile, int wave, int lane) {
#pragma unroll
    for (int i = 0; i < 2; ++i) { const int chunk = i * 8 + wave;
        __builtin_amdgcn_global_load_lds((const unsigned*)(img + (size_t)tile * ATT_TILEB + 16384 + chunk * 1024 + lane * 16), (LAS unsigned*)(lds + ATT_VRING + (tile % 3) * 16384 + chunk * 1024), 16, 0, 0); }
}
__device__ __forceinline__ void attn_unit(const Frame& F, int l, int b, int h, int row0, int nt, float lam, float post) {
    LAS unsigned char* lds = F.lds;
    const int wave = F.wave, lane = F.lane, qg = wave >> 1, map = wave & 1, ql = lane & 31, hi = lane >> 5;
    const unsigned char* img = F.ws + WS_KV + (size_t)(b * 4 + h) * NT_LAT * ATT_TILEB;
    const int row = row0 + qg * 32 + ql;
    const bf16_t* Q = (const bf16_t*)(F.ws + WS_QKV) + (size_t)row * LDQ + OQ + h * 128 + map * 64 + hi * 8;
    bf16x8 qf[4];
#pragma unroll
    for (int ks = 0; ks < 4; ++ks) qf[ks] = *(const bf16x8*)(Q + 16 * ks);
    att_issue_k(lds, img, 0, wave, lane); att_issue_k(lds, img, 1, wave, lane); att_issue_v(lds, img, 0, wave, lane);
    f32x16 o[4];
#pragma unroll
    for (int dt = 0; dt < 4; ++dt)
#pragma unroll
        for (int r = 0; r < 16; ++r) o[dt][r] = 0.f;
    float mref = -1.0e30f, lsum = 0.f, pend = 1.0f;
    const int koff = ATT_KRING + map * 8192 + (hi * 64 + ql) * 16, voff = ATT_VRING + (hi * 32 + ql) * 16;
    u32x4 pfp[4], pfn[4];
#pragma unroll
    for (int j = 0; j < 4; ++j) pfp[j] = (u32x4){0u, 0u, 0u, 0u};
    for (int t = 0; t < nt; ++t) {
        if (t + 1 < nt) ATT_WAITV(4); else ATT_WAITV(2);
        ATT_BAR();
        if (t + 2 < nt) att_issue_k(lds, img, t + 2, wave, lane);
        if (t + 1 < nt) att_issue_v(lds, img, t + 1, wave, lane);
        const float sbias = mref < -1.0e29f ? 0.f : mref;
        f32x16 s0, s1;
        {
            const LAS unsigned char* kp = lds + koff + (t % 3) * 16384;
            bf16x8 kf[8];
#pragma unroll
            for (int ks = 0; ks < 4; ++ks) { kf[2 * ks] = *(const LAS bf16x8*)(kp + ks * 2048); kf[2 * ks + 1] = *(const LAS bf16x8*)(kp + ks * 2048 + 512); }
#pragma unroll
            for (int r = 0; r < 16; ++r) { s0[r] = -sbias; s1[r] = -sbias; }
            __builtin_amdgcn_sched_barrier(0);
#pragma unroll
            for (int ks = 0; ks < 4; ++ks) { s0 = __builtin_amdgcn_mfma_f32_32x32x16_bf16(kf[2 * ks], qf[ks], s0, 0, 0, 0); s1 = __builtin_amdgcn_mfma_f32_32x32x16_bf16(kf[2 * ks + 1], qf[ks], s1, 0, 0, 0); }
        }
        const LAS unsigned char* vp = t > 0 ? lds + voff + ((t + 2) % 3) * 16384 : lds + ATT_KRING + (hi * 32 + ql) * 16;
        bf16x8 vfr[4];
#pragma unroll
        for (int i = 0; i < 3; ++i) vfr[i] = *(const LAS bf16x8*)(vp + (i * 2) * 512);
        float mx = fmaxf(fmaxf(s0[0], s1[0]), fmaxf(s0[1], s1[1]));
#pragma unroll
        for (int r = 2; r < 16; r += 2) mx = fmaxf(fmaxf(mx, s0[r]), fmaxf(s1[r], fmaxf(s0[r + 1], s1[r + 1])));
        { const auto rr = __builtin_amdgcn_permlane32_swap(__float_as_uint(mx), __float_as_uint(mx), false, false);
          mx = fmaxf(__uint_as_float(rr[0]), __uint_as_float(rr[1])) + sbias; }
        if (__any(pend != 1.0f || mx > mref + 8.0f)) {
#pragma unroll
            for (int dt = 0; dt < 4; ++dt)
#pragma unroll
                for (int r = 0; r < 16; ++r) o[dt][r] *= pend;
            const float mnew = (mx > mref + 8.0f) ? mx : mref, delta = sbias - mnew;
            pend = __builtin_amdgcn_exp2f(mref - mnew);
#pragma unroll
            for (int r = 0; r < 16; ++r) { s0[r] += delta; s1[r] += delta; }
            lsum *= pend; mref = mnew;
        }
        __builtin_amdgcn_sched_barrier(0);
        float ps = 0.f;
#pragma unroll
        for (int i = 0; i < 16; ++i) {
            if (i + 3 < 16) vfr[(i + 3) & 3] = *(const LAS bf16x8*)(vp + ((i + 3) * 2) * 512);
            o[i >> 2] = __builtin_amdgcn_mfma_f32_32x32x16_bf16(vfr[i & 3], __builtin_bit_cast(bf16x8, pfp[i & 3]), o[i >> 2], 0, 0, 0);
            s0[i] = __builtin_amdgcn_exp2f(s0[i]); s1[i] = __builtin_amdgcn_exp2f(s1[i]); ps += s0[i]; ps += s1[i];
            if (i & 1) { pfn[i >> 3][(i & 7) >> 1] = cvtpk(s0[i - 1], s0[i]); pfn[2 + (i >> 3)][(i & 7) >> 1] = cvtpk(s1[i - 1], s1[i]); }
            __builtin_amdgcn_sched_barrier(0);
        }
        lsum += ps;
#pragma unroll
        for (int j = 0; j < 4; ++j) pfp[j] = pfn[j];
    }
    ATT_WAITV(0); ATT_BAR();
    {
#pragma unroll
        for (int dt = 0; dt < 4; ++dt)
#pragma unroll
            for (int r = 0; r < 16; ++r) o[dt][r] *= pend;
        const LAS unsigned char* vp = lds + voff + ((nt - 1) % 3) * 16384;
#pragma unroll
        for (int hf = 0; hf < 2; ++hf) { bf16x8 vf[8];
#pragma unroll
            for (int i = 0; i < 8; ++i) vf[i] = *(const LAS bf16x8*)(vp + ((hf * 8 + i) * 2) * 512);
            __builtin_amdgcn_sched_barrier(0);
#pragma unroll
            for (int i = 0; i < 8; ++i) o[hf * 2 + (i >> 2)] = __builtin_amdgcn_mfma_f32_32x32x16_bf16(vf[i], __builtin_bit_cast(bf16x8, pfp[i & 3]), o[hf * 2 + (i >> 2)], 0, 0, 0); }
    }
    const float ltot = lsum + __shfl_xor(lsum, 32);
    LAS unsigned* xch = (LAS unsigned*)(lds + ATT_XCH + qg * 8192);
    if (map == 1) { const float sc = lam / ltot;
#pragma unroll
        for (int dt = 0; dt < 4; ++dt)
#pragma unroll
            for (int r = 0; r < 16; r += 2) xch[(dt * 8 + (r >> 1)) * 64 + lane] = cvtpk(o[dt][r] * sc, o[dt][r + 1] * sc); }
    ATT_BAR();
    if (map == 0) { const float inv = 1.0f / ltot; float ss = 0.f;
#pragma unroll
        for (int dt = 0; dt < 4; ++dt)
#pragma unroll
            for (int r = 0; r < 16; r += 2) { const unsigned w = xch[(dt * 8 + (r >> 1)) * 64 + lane]; o[dt][r] = o[dt][r] * inv - bflo(w); o[dt][r + 1] = o[dt][r + 1] * inv - bfhi(w); ss += o[dt][r] * o[dt][r] + o[dt][r + 1] * o[dt][r + 1]; }
        ss += __shfl_xor(ss, 32);
        const float sc = post / sqrtf(ss * (1.0f / 128.0f) + SUBLN_EPS);
        const float* sg = F.in[I_SUBLN] + l * 128;
        bf16_t* orow = (bf16_t*)(F.ws + WS_ACT) + (size_t)row * D + h * 128;
#pragma unroll
        for (int dt = 0; dt < 4; ++dt)
#pragma unroll
            for (int rq = 0; rq < 4; ++rq) { const int d = 32 * dt + 8 * rq + 4 * hi; const f32x4 g = *(const f32x4*)(sg + d);
                u32x2 w; w.x = cvtpk(o[dt][4 * rq] * sc * g[0], o[dt][4 * rq + 1] * sc * g[1]); w.y = cvtpk(o[dt][4 * rq + 2] * sc * g[2], o[dt][4 * rq + 3] * sc * g[3]);
                *(u32x2*)(orow + d) = w; }
    }
}
__device__ __forceinline__ void ph_attn(const Frame& F0, int l) {
    const Frame F = fresh(F0);
    const float lam = ((const float*)(F.ws + WS_LAM))[l];
    const float post = 1.0f - (0.8f - 0.6f * expf(-0.3f * (float)l));
    constexpr int NU_LAT = NB * 4 * (T / 128);
    for (int U = F.bid; U < NU_LAT; U += F.G) {
        const int x = U & 7, j = (U >> 3) & 31, i = U >> 8, pair = x + 8 * i;
        attn_unit(F, l, pair >> 2, pair & 3, (pair >> 2) * T + j * 128, NT_LAT, lam, post);
    }
    if (l < DEPTH - 1)
        for (int U = F.bid; U < NB * 4 * (CT / 128); U += F.G) { const int pair = U >> 1, qb = U & 1;
            attn_unit(F, l, pair >> 2, pair & 3, BT + (pair >> 2) * CT + qb * 128, NT_CTX, lam, post); }
}
__device__ __forceinline__ float row16_sum(float v) { v = DPP_ADD(v, 0xB1); v = DPP_ADD(v, 0x4E); v = DPP_ADD(v, 0x141); v = DPP_ADD(v, 0x140); return v; }
__device__ __forceinline__ void ph_rwkv_out(const Frame& F0, int l) {
    const Frame F = fresh(F0);
    constexpr int R = 4;
    const int nrows = l < DEPTH - 1 ? M : BT;
    const int c4 = 4 * F.lane, h = F.lane >> 4;
    const bf16_t* RW = (const bf16_t*)(F.ws + WS_R2); const unsigned* YD2 = (const unsigned*)(F.ws + WS_YD); bf16_t* MIX = (bf16_t*)(F.ws + WS_ACT);
    const f32x4 gg = *(const f32x4*)(F.in[I_GNG] + l * 256 + c4), gb = *(const f32x4*)(F.in[I_GNB] + l * 256 + c4);
    for (int grp = F.bid * NWAVES + F.wave; grp < nrows / R; grp += F.G * NWAVES) {
        u32x2 vv[R], gt[R]; float bon[R]; u32x4 ya[2], yb[2];
#pragma unroll
        for (int q = 0; q < 2; ++q) { const size_t o2 = (size_t)(grp * 2 + q) * 256 + c4; ya[q] = __builtin_nontemporal_load((const u32x4*)(YD2 + o2)); yb[q] = __builtin_nontemporal_load((const u32x4*)(YD2 + (size_t)(M / 2) * 256 + o2)); }
#pragma unroll
        for (int r = 0; r < R; ++r) { const size_t o = (size_t)(grp * R + r) * 256 + c4;
            vv[r] = __builtin_nontemporal_load((const u32x2*)(RW + RW_V * (RWSZ / 2) + o)); gt[r] = __builtin_nontemporal_load((const u32x2*)(RW + RW_G * (RWSZ / 2) + o));
            bon[r] = ((const float*)(F.ws + WS_BONUS))[(size_t)(grp * R + r) * 4 + h]; }
#pragma unroll
        for (int r = 0; r < R; ++r) {
            const u32x4 wa = ya[r >> 1], wb = yb[r >> 1];
            f32x4 y = (r & 1) ? (f32x4){bfhi(wa[0]) + bfhi(wb[0]), bfhi(wa[1]) + bfhi(wb[1]), bfhi(wa[2]) + bfhi(wb[2]), bfhi(wa[3]) + bfhi(wb[3])}
                              : (f32x4){bflo(wa[0]) + bflo(wb[0]), bflo(wa[1]) + bflo(wb[1]), bflo(wa[2]) + bflo(wb[2]), bflo(wa[3]) + bflo(wb[3])};
            const float mu = row16_sum((y[0] + y[1]) + (y[2] + y[3])) * (1.0f / 64.0f); y = y - mu;
            const float var = row16_sum((y[0] * y[0] + y[1] * y[1]) + (y[2] * y[2] + y[3] * y[3])) * (1.0f / 64.0f);
            const float rs = 1.0f / sqrtf(var + GN_EPS);
            const f32x4 v4 = (f32x4){bflo(vv[r].x), bfhi(vv[r].x), bflo(vv[r].y), bfhi(vv[r].y)}, g4 = (f32x4){bflo(gt[r].x), bfhi(gt[r].x), bflo(gt[r].y), bfhi(gt[r].y)};
            const f32x4 o4 = (y * rs * gg + gb + bon[r] * v4) * g4;
            *(u32x2*)(MIX + (size_t)(grp * R + r) * D + 512 + c4) = (u32x2){cvtpk(o4[0], o4[1]), cvtpk(o4[2], o4[3])};
        }
    }
}

constexpr int NSL = 12, NSTEP = 2 + NSL * DEPTH;
#ifndef GEMM_MASK
#define GEMM_MASK 63
#endif
#if (GEMM_MASK >> 0) & 1
#define GEMMCALL0(a, b, c, d) pg8::gemm_phase(a, b, c, d, F.wave)
#else
#define GEMMCALL0(a, b, c, d) do {} while (0)
#endif
#if (GEMM_MASK >> 1) & 1
#define GEMMCALL1(a, b, c, d) pg8::gemm_phase(a, b, c, d, F.wave)
#else
#define GEMMCALL1(a, b, c, d) do {} while (0)
#endif
#if (GEMM_MASK >> 2) & 1
#define GEMMCALL2(a, b, c, d) pg8::gemm_phase(a, b, c, d, F.wave)
#else
#define GEMMCALL2(a, b, c, d) do {} while (0)
#endif
#if (GEMM_MASK >> 3) & 1
#define GEMMCALL3(a, b, c, d) pg8::gemm_phase(a, b, c, d, F.wave)
#else
#define GEMMCALL3(a, b, c, d) do {} while (0)
#endif
#if (GEMM_MASK >> 4) & 1
#define GEMMCALL4(a, b, c, d) pg8::gemm_phase(a, b, c, d, F.wave)
#else
#define GEMMCALL4(a, b, c, d) do {} while (0)
#endif
#if (GEMM_MASK >> 5) & 1
#define GEMMCALL5(a, b, c, d) pg8::gemm_phase(a, b, c, d, F.wave)
#else
#define GEMMCALL5(a, b, c, d) do {} while (0)
#endif
__global__ void __launch_bounds__(NTHR, 2) fwd_kernel(Args args) {
    extern __shared__ __attribute__((aligned(16))) unsigned char lds_raw[];
    Frame F;
    F.lds = (LAS unsigned char*)lds_raw;
    F.tid = threadIdx.x; F.lane = F.tid & 63; F.wave = __builtin_amdgcn_readfirstlane(F.tid >> 6);
    F.G = gridDim.x; F.bid = blockIdx.x;
    F.in = args.in; F.out = args.out; F.ws = args.ws; F.ctl = (unsigned*)(args.ws + WS_CTL);
    volatile LAS unsigned* MISC = (volatile LAS unsigned*)(F.lds + MISC_OFF);
    for (int u = F.tid; u < (LDS_BYTES - RING_BYTES) / 4; u += NTHR) ((LAS unsigned*)(F.lds + RING_BYTES))[u] = 0u;
    __syncthreads();
    const int s_lo = args.s_lo, s_hi = args.s_hi;
    XcdBarrier bar; bar.bar = F.ctl + CW_BAR; bar.x = 0; bar.st = nullptr;
    if (s_hi - s_lo > 1) bar = xcd_barrier_post(F.ctl + CW_BAR, MISC + 8);
#define IN(s) (s_lo <= (s) && (s) < s_hi)
#ifndef PROBE_BAR2
#define PROBE_BAR2 0
#endif
#define SEAM(s) do { if ((s) + 1 < s_hi) { xcd_barrier(bar, F.wave); if (PROBE_BAR2) xcd_barrier(bar, F.wave); } } while (0)
#define REPS(k) (((REP_MASK >> (k)) & 1) ? 2 : 1)

#ifndef DIS_PRE
    if (IN(0)) { _Pragma("nounroll") for (int rp = 0; rp < REPS(0); ++rp) { ph_mods(F, 0, 1, F.bid, F.G); ph_convert(F, 0, 0, F.bid, F.G); } SEAM(0); }
#endif
#ifndef DIS_LN
    if (IN(1)) { _Pragma("nounroll") for (int rp = 0; rp < REPS(9); ++rp) { ph_ln<0>(F, 0, rp + 1 < REPS(9)); } SEAM(1); }
#endif
    for (int l = 0; l < DEPTH; ++l) {
        const int sb = 2 + NSL * l;
        const int mact = l < DEPTH - 1 ? M : BT;
        const float* gates = (const float*)(F.ws + WS_MODS) + (size_t)l * 9 * 6 * D;
        if (IN(sb + 0)) {
            pg8::Gemm g{(const bf16_t*)(F.ws + WS_ACT), (const bf16_t*)(F.ws + WS_WIN), D, 0}; pg8::StaticOrder S; S.init(M, NPROJP, F.G, F.bid);
            pg8::EpiBf16 E{(bf16_t*)(F.ws + WS_QKV), LDQ, (bf16_t*)(F.ws + WS_REST), LDR, 6};
            _Pragma("nounroll") for (int rp = 0; rp < REPS(1); ++rp) { GEMMCALL0(F.lds, g, S, E); } SEAM(sb + 0);
        }
#ifndef DIS_PREP
        if (IN(sb + 1)) { _Pragma("nounroll") for (int rp = 0; rp < REPS(8); ++rp) { ph_prep(F, l, rp + 1 == REPS(8)); } SEAM(sb + 1); }
#endif
#ifndef DIS_ATTN
        if (IN(sb + 2)) { _Pragma("nounroll") for (int rp = 0; rp < REPS(2); ++rp) { ph_attn(F, l); } SEAM(sb + 2); }
#endif
#ifndef DIS_SCAN
        if (IN(sb + 3)) { _Pragma("nounroll") for (int rp = 0; rp < REPS(3); ++rp) { ph_prep3f(F, l); } SEAM(sb + 3); }
        if (IN(sb + 4)) {
            if (F.bid >= 64 && F.G > 64) { if (l == 0) ph_mods(F, 1, DEPTH, F.bid - 64, F.G - 64); ph_convert(F, l, 1, F.bid - 64, F.G - 64); }
            else { if (F.G <= 64) { if (l == 0) ph_mods(F, 1, DEPTH, F.bid, F.G); ph_convert(F, l, 1, F.bid, F.G); __syncthreads(); }
                   _Pragma("nounroll") for (int rp = 0; rp < REPS(4); ++rp) { ph_seqscan(F, l); __syncthreads(); } }
            SEAM(sb + 4); }
#endif
#ifndef DIS_ROUT
        if (IN(sb + 5)) { _Pragma("nounroll") for (int rp = 0; rp < REPS(5); ++rp) { ph_rwkv_out(F, l); } SEAM(sb + 5); }
#endif
        if (IN(sb + 6)) {
            pg8::Gemm g{(const bf16_t*)(F.ws + WS_ACT), (const bf16_t*)(F.ws + WS_WOUT), D, 0}; pg8::SplitOrder S; S.init(D, 4, D / 64, l < DEPTH - 1, F.G, F.bid);
            _Pragma("nounroll") for (int rp = 0; rp < REPS(11); ++rp) { pg8::EpiDelta E{(bf16_t*)(F.ws + WS_R1), gates + 2 * D, (bf16_t*)(F.ws + WS_R1 + 68 * MiB)};
            GEMMCALL1(F.lds, g, S, E); } SEAM(sb + 6);
        }
#ifndef DIS_LN
        if (IN(sb + 7)) { _Pragma("nounroll") for (int rp = 0; rp < REPS(9); ++rp) { ph_ln<1>(F, l, rp + 1 < REPS(9)); } SEAM(sb + 7); }
#endif
        if (l & 1) {
#ifndef DIS_GATH
            if (IN(sb + 8)) { ph_moe_gather(F, l); SEAM(sb + 8); }
#endif
            if (IN(sb + 9)) {
                pg8::Gemm g{(const bf16_t*)(F.ws + WS_ACT), (const bf16_t*)(F.ws + WS_WFF), D, (size_t)2 * DFFE * D * 2}; pg8::MoeGatherOrder S; S.init(F.ctl + CW_CNT + 64 * (l >> 1), 2 * DFFE, F.G, F.bid); S.tok = (const int*)(F.ws + WS_TOK);
                pg8::EpiSwiGLU E{(bf16_t*)(F.ws + WS_R1), DFFE};
                _Pragma("nounroll") for (int rp = 0; rp < REPS(15); ++rp) { GEMMCALL2(F.lds, g, S, E); } SEAM(sb + 9);
            }
            if (IN(sb + 10)) {
                pg8::Gemm g{(const bf16_t*)(F.ws + WS_R1), (const bf16_t*)(F.ws + WS_WFF2), DFFE, (size_t)D * DFFE * 2}; pg8::MoeOrder S; S.init(F.ctl + CW_CNT + 64 * (l >> 1), D, F.G, F.bid);
                pg8::EpiBf16 E{(bf16_t*)(F.ws + WS_R2), D, nullptr, 0, 0};
                _Pragma("nounroll") for (int rp = 0; rp < REPS(7); ++rp) { GEMMCALL3(F.lds, g, S, E); } SEAM(sb + 10);
            }
        } else {
            if (IN(sb + 8)) { SEAM(sb + 8); }
            if (IN(sb + 9)) {
                pg8::Gemm g{(const bf16_t*)(F.ws + WS_ACT), (const bf16_t*)(F.ws + WS_WFF), D, 0}; pg8::StaticOrder S; S.init(mact, 2 * DFF, F.G, F.bid);
                pg8::EpiSwiGLU E{(bf16_t*)(F.ws + WS_R1), DFF};
                _Pragma("nounroll") for (int rp = 0; rp < REPS(6); ++rp) { GEMMCALL4(F.lds, g, S, E); } SEAM(sb + 9);
            }
            if (IN(sb + 10)) {
                pg8::Gemm g{(const bf16_t*)(F.ws + WS_R1), (const bf16_t*)(F.ws + WS_WFF2), DFF, 0}; pg8::SplitOrder S; S.init(D, 2, DFF / 64, l < DEPTH - 1, F.G, F.bid);
                _Pragma("nounroll") for (int rp = 0; rp < REPS(12); ++rp) { pg8::EpiDelta E{(bf16_t*)(F.ws + WS_R2), gates + 5 * D, (bf16_t*)(F.ws + WS_R2 + 68 * MiB)};
                GEMMCALL5(F.lds, g, S, E); } SEAM(sb + 10);
            }
        }
#ifndef DIS_LN
        if (IN(sb + 11)) { _Pragma("nounroll") for (int rp = 0; rp < REPS(9); ++rp) { ph_ln<2>(F, l, rp + 1 < REPS(9)); } _Pragma("nounroll") for (int rp = 0; rp < REPS(10); ++rp) { if (l + 1 < DEPTH) ph_convert(F, l + 1, 0, F.bid, F.G); } SEAM(sb + 11); }
#endif
    }
}

#ifndef MK_PER_STEP
#define MK_PER_STEP 0
#endif
extern "C" void kernel_launch(void* const* d_in, const int* in_sizes, int n_in, void* d_out, int out_size, void* d_ws, size_t ws_size, hipStream_t stream) {
    static int grid = 0;
    if (grid == 0) {
        if (n_in != 37 || out_size != BT * D || ws_size < WS_END) { fprintf(stderr, "kernel_launch: unexpected problem (n_in %d out %d ws %zu, need %zu)\n", n_in, out_size, ws_size, (size_t)WS_END); grid = -1; return; }
        int dev = 0, cus = 0, per_cu = 0;
        if (hipGetDevice(&dev) != hipSuccess || hipDeviceGetAttribute(&cus, hipDeviceAttributeMultiprocessorCount, dev) != hipSuccess) { grid = -1; return; }
        if (hipFuncSetAttribute((const void*)fwd_kernel, hipFuncAttributeMaxDynamicSharedMemorySize, LDS_BYTES) != hipSuccess) { fprintf(stderr, "kernel_launch: hipFuncSetAttribute failed\n"); grid = -1; return; }
        if (hipOccupancyMaxActiveBlocksPerMultiprocessor(&per_cu, (const void*)fwd_kernel, NTHR, LDS_BYTES) != hipSuccess || per_cu < 1) { fprintf(stderr, "kernel_launch: occupancy query says %d\n", per_cu); grid = -1; return; }
        grid = cus;
    }
    if (grid <= 0) return;
    hipMemsetAsync((char*)d_ws + WS_CTL, 0, CTL_ZERO_BYTES, stream);
    Args a{};
    for (int i = 0; i < 37; ++i) a.in[i] = (const float*)d_in[i];
    a.out = (float*)d_out; a.ws = (unsigned char*)d_ws;
#if MK_PER_STEP
    for (int s = 0; s < NSTEP; ++s) { a.s_lo = s; a.s_hi = s + 1; hipLaunchKernelGGL(fwd_kernel, dim3(grid), dim3(NTHR), LDS_BYTES, stream, a); }
#else
    a.s_lo = 0; a.s_hi = NSTEP; hipLaunchKernelGGL(fwd_kernel, dim3(grid), dim3(NTHR), LDS_BYTES, stream, a);
#endif
}
```

```cpp
#include <hip/hip_runtime.h>
#define REP_MASK 0
#include <cstdio>
#include <cstdint>

#define LAS __attribute__((address_space(3)))
typedef unsigned short bf16_t;
typedef short bf16x8 __attribute__((ext_vector_type(8)));
typedef float f32x4 __attribute__((ext_vector_type(4)));
typedef float f32x2 __attribute__((ext_vector_type(2)));
typedef unsigned u32x4 __attribute__((ext_vector_type(4)));
typedef unsigned u32x2 __attribute__((ext_vector_type(2)));
typedef short bf16x4s __attribute__((ext_vector_type(4)));
#define BF4(v) __builtin_bit_cast(bf16x4s, (v))

constexpr int NB = 8, T = 4096, CT = 256, D = 1024, DEPTH = 4, GW = 64;
constexpr int BT = NB * T, BC = NB * CT, M = BT + BC;
constexpr int NPROJ = 3264, NPROJP = 3328;
constexpr int OQ = 0, OK_ = 512, OV = 1024;
constexpr int ORR = 0, ORK = 256, ORV = 512, OWD = 768, OAD = 832, OGD = 896, OCH = 960, OCB = 1216, OCC = 1472;
constexpr int DFF = 2816, NE = 8, DFFE = 1408;
constexpr int MPADMAX = 2 * M + NE * 256;
constexpr float DN_ALPHA = 1.681792830507429f;
constexpr float LN_EPS = 1e-5f, SUBLN_EPS = 1e-5f, GN_EPS = 64e-5f;
constexpr float LOG2E = 1.4426950408889634f;

constexpr size_t MiB = 1u << 20;
constexpr size_t WS_CTL = 0, CTL_ZERO_BYTES = 1 * MiB;
constexpr size_t WS_MODS = 1 * MiB;
constexpr size_t WS_LAM = WS_MODS + 960 * 1024;
constexpr size_t WS_LW = WS_MODS + 884736;
constexpr size_t WS_WIN = 2 * MiB;
constexpr size_t WS_WOUT = WS_WIN + 6 * MiB + MiB / 2;
constexpr size_t WS_WFF = WS_WOUT + 2 * MiB;
constexpr size_t WS_WFF2 = WS_WFF + 44 * MiB;
constexpr size_t WS_XSC = WS_WFF + 66 * MiB;
constexpr size_t WS_ACT = WS_XSC + 8 * MiB;
constexpr size_t WS_R1 = WS_ACT + 68 * MiB;
constexpr size_t WS_QKV = WS_R1, WS_REST = WS_R1 + 102 * MiB;
constexpr int LDQ = 1536, LDR = 1792;
constexpr size_t WS_R2 = WS_R1 + 221 * MiB;
constexpr size_t RWSZ = (size_t)M * 256 * 2;
constexpr size_t WS_CH = WS_R1;
constexpr size_t WS_KV = WS_R2 + 10 * RWSZ;
constexpr size_t WS_YD = WS_KV;
constexpr size_t WS_BONUS = WS_KV + 68 * MiB;
constexpr size_t WS_MISC = WS_R2 + 239 * MiB;
constexpr size_t WS_TOPE = WS_MISC, WS_TOPG = WS_MISC + 256 * 1024, WS_SLOT = WS_MISC + 640 * 1024;
constexpr size_t WS_TOK = WS_MISC + 1 * MiB;
constexpr size_t WS_END = WS_MISC + 2 * MiB;
static_assert(WS_BONUS + (size_t)M * 16 <= WS_MISC, "ws map");
static_assert((size_t)MPADMAX * 1024 * 2 <= 239 * MiB && (size_t)MPADMAX * DFFE * 2 <= 221 * MiB, "moe buffers");
static_assert((size_t)M * LDQ * 2 == 102 * MiB && (size_t)M * LDR * 2 <= 119 * MiB && 2 * RWSZ <= 68 * MiB && (size_t)64 * 272 * 12544 <= 221 * MiB, "R1 split");
enum { RW_V = 0, RW_G = 1 };
constexpr int CW_BAR = 4096;
constexpr int CW_CNT = 8192, CW_CUR = 8192 + 256, CW_ATT = 8192 + 512;
constexpr int CW_PROG = 16384;

__host__ __device__ constexpr size_t ch_off_c(int chain) { return chain < 31 ? WS_R1 + (size_t)chain * 272 * 12544 : WS_R2 + 34 * MiB + (size_t)(chain - 31) * 272 * 12544; }
static_assert(ch_off_c(31) == WS_R2 + 34 * MiB && (size_t)31 * 272 * 12544 <= 102 * MiB && 34 * MiB + (size_t)33 * 272 * 12544 <= 170 * MiB, "chunk-record placement: part A over the dead QKV buffer, part B between the V/G arrays and the KV images");
__device__ __forceinline__ unsigned f2bf(float f) { unsigned u = __builtin_bit_cast(unsigned, f); return (u + 0x7fffu + ((u >> 16) & 1u)) >> 16; }
__device__ __forceinline__ unsigned pk2(float lo, float hi) { return f2bf(lo) | (f2bf(hi) << 16); }
typedef __bf16 bf16x2_t __attribute__((ext_vector_type(2)));
__device__ __forceinline__ unsigned cvtpk(float lo, float hi) { const f32x2 v = {lo, hi}; return __builtin_bit_cast(unsigned, __builtin_convertvector(v, bf16x2_t)); }
__device__ __forceinline__ float bf2f(unsigned short h) { return __builtin_bit_cast(float, (unsigned)h << 16); }
__device__ __forceinline__ float bflo(unsigned w) { return __builtin_bit_cast(float, w << 16); }
__device__ __forceinline__ float bfhi(unsigned w) { return __builtin_bit_cast(float, w & 0xffff0000u); }
__device__ __forceinline__ float rdl(float x, int k) { return __builtin_bit_cast(float, __builtin_amdgcn_readlane(__builtin_bit_cast(int, x), k)); }
#define DPP_ADD(v, ctrl) ((v) + __builtin_bit_cast(float, __builtin_amdgcn_update_dpp(0, __builtin_bit_cast(int, (v)), (ctrl), 0xf, 0xf, true)))
__device__ __forceinline__ float wave_sum(float v) {
    v = DPP_ADD(v, 0xB1);
    v = DPP_ADD(v, 0x4E);
    v = DPP_ADD(v, 0x141);
    v = DPP_ADD(v, 0x140);
    return (rdl(v, 0) + rdl(v, 16)) + (rdl(v, 32) + rdl(v, 48));
}
__device__ __forceinline__ float wave_max(float v) {
#pragma unroll
    for (int o = 1; o < 64; o <<= 1) v = fmaxf(v, __shfl_xor(v, o));
    return v;
}
__device__ __forceinline__ float sigmoidf_(float x) { return __builtin_amdgcn_rcpf(1.0f + __builtin_amdgcn_exp2f(-LOG2E * x)); }

namespace pg8 {
#define PG8_LAS __attribute__((address_space(3)))
constexpr int BM = 256, BK = 64, HALF = 128, HTB = HALF * BK * 2, STAGE_BYTES = 8 * HTB;
__host__ __device__ __forceinline__ int lds_byte(int r, int c) { const int st = (r >> 4) * 2 + (c >> 5), rr = r & 15, cc = c & 31, ob = rr * 64 + cc * 2; return st * 1024 + (ob ^ (((ob >> 9) & 1) << 5)); }
__host__ __device__ __forceinline__ void stage_rc(int b, int& R, int& C) { const int st = b / 1024, sb = b % 1024, swz = sb ^ (((sb >> 9) & 1) << 5); R = (st >> 1) * 16 + swz / 64; C = (st & 1) * 32 + (swz % 64) / 2; }
__host__ __device__ __forceinline__ int perm32(int rho) { const int n = rho >> 4, i = rho & 15; return 8 * (i >> 2) + 4 * n + (i & 3); }

struct Unit { int pm, pn, e, k0, nk, ks; };
struct Gemm { const bf16_t* A; const bf16_t* Bt; int K; size_t estride; };

struct StaticOrder {
    static constexpr bool KSPLIT = false, GATHER = false;
    int nM, nN, nwg, G, c;
    __device__ void init(int Mrows, int N, int G_, int c_) { nM = Mrows / BM; nN = N / BM; nwg = nM * nN; G = G_; c = c_; }
    __device__ bool next(int i, Unit& u) const {
        int L = i * G + c; if (L >= nwg) return false;
        { const int q = nwg / 8, r = nwg % 8, xcd = L % 8, off = L / 8; L = (xcd < r ? xcd * (q + 1) : r * (q + 1) + (xcd - r) * q) + off; }
        const int nig = 8 * nN, gid = L / nig, fm = gid * 8, gsz = (nM - fm) < 8 ? (nM - fm) : 8;
        u.pm = fm + ((L % nig) % gsz); u.pn = (L % nig) / gsz; u.e = 0; u.k0 = 0; u.nk = 0; u.ks = 0; return true;
    }
};
struct MoeOrder {
    static constexpr bool KSPLIT = false, GATHER = false;
    int tb[NE + 1]; int nN, nwg, G, c;
    __device__ void init(const unsigned* cnt, int N, int G_, int c_) {
        int t = 0;
#pragma unroll
        for (int e = 0; e < NE; ++e) { tb[e] = t; t += (int)((__hip_atomic_load(cnt + e, __ATOMIC_RELAXED, __HIP_MEMORY_SCOPE_AGENT) + 255u) >> 8); }
        tb[NE] = t; nN = N / BM; nwg = t * nN; G = G_; c = c_;
    }
    __device__ bool next(int i, Unit& u) const {
        int L = i * G + c; if (L >= nwg) return false;
        { const int q = nwg / 8, r = nwg % 8, xcd = L % 8, off = L / 8; L = (xcd < r ? xcd * (q + 1) : r * (q + 1) + (xcd - r) * q) + off; }
        u.pm = L / nN; u.pn = L % nN; int e = 0;
#pragma unroll
        for (int k = 1; k < NE; ++k) e += (u.pm >= tb[k]) ? 1 : 0;
        u.e = e; u.k0 = 0; u.nk = 0; u.ks = 0; return true;
    }
};

struct SplitOrder {
    static constexpr bool KSPLIT = true, GATHER = false;
    int nN, nL, nC, S, NT, G, c;
    __device__ void init(int N, int S_, int NT_, bool with_ctx, int G_, int c_) { nN = N / BM; nL = (BT / BM) * nN; S = S_; NT = NT_; nC = with_ctx ? (BC / BM) * nN * S_ : 0; G = G_; c = c_; }
    __device__ bool next(int i, Unit& u) const {
        const int L0 = i * G + c; if (L0 >= nL + nC) return false;
        int pm, pn, k0 = 0, nk = NT, ks = 0;
        if (L0 < nL) { int L = L0; { const int q = nL / 8, r = nL % 8, xcd = L % 8, off = L / 8; L = (xcd < r ? xcd * (q + 1) : r * (q + 1) + (xcd - r) * q) + off; }
            const int nig = 8 * nN, gid = L / nig, fm = gid * 8; pm = fm + ((L % nig) & 7); pn = (L % nig) >> 3; }
        else { const int idx = L0 - nL, q = idx / S; ks = idx - q * S; pn = q % nN; pm = BT / BM + q / nN; nk = NT / S; k0 = ks * nk; }
        u.pm = pm; u.pn = pn; u.e = 0; u.k0 = k0; u.nk = nk; u.ks = ks; return true;
    }
};
struct MoeGatherOrder : MoeOrder {
    static constexpr bool GATHER = true;
    const int* tok;
    __device__ __forceinline__ int row_of(int slot) const { return tok[slot]; }
};
__device__ __forceinline__ unsigned cvt_pk_bf16(float lo, float hi) { unsigned r; asm volatile("v_cvt_pk_bf16_f32 %0, %1, %2" : "=v"(r) : "v"(lo), "v"(hi)); return r; }

struct EpiBf16 {
    static constexpr bool PERM = true;
    bf16_t* O; int ldc; bf16_t* O1; int ldc1; int psplit;
    __device__ __forceinline__ void operator()(const f32x4 (&acc)[2][2][4][2], const Unit& u, int wr, int wc, int fr, int fq) const {
        const bool second = psplit > 0 && u.pn >= psplit;
        bf16_t* base = second ? O1 : O; const int ld = second ? ldc1 : ldc;
        const int row0 = u.pm * BM + wr * 64 + fr, col0 = (second ? u.pn - psplit : u.pn) * BM + wc * 32 + 8 * fq;
#pragma unroll
        for (int ai = 0; ai < 2; ++ai)
#pragma unroll
            for (int m = 0; m < 4; ++m) { bf16_t* rowp = base + (size_t)(row0 + ai * HALF + m * 16) * ld + col0;
#pragma unroll
                for (int bj = 0; bj < 2; ++bj) { const f32x4 v0 = acc[ai][bj][m][0], v1 = acc[ai][bj][m][1];
                    u32x4 w; w.x = cvt_pk_bf16(v0[0], v0[1]); w.y = cvt_pk_bf16(v0[2], v0[3]); w.z = cvt_pk_bf16(v1[0], v1[1]); w.w = cvt_pk_bf16(v1[2], v1[3]);
                    *(u32x4*)(rowp + bj * HALF) = w; } }
    }
};
struct EpiSwiGLU {
    static constexpr bool PERM = true;
    bf16_t* H; int ldh;
    __device__ __forceinline__ void operator()(const f32x4 (&acc)[2][2][4][2], const Unit& u, int wr, int wc, int fr, int fq) const {
        const int row0 = u.pm * BM + wr * 64 + fr, h0 = u.pn * 128 + wc * 16 + 4 * fq;
#pragma unroll
        for (int ai = 0; ai < 2; ++ai)
#pragma unroll
            for (int m = 0; m < 4; ++m) { bf16_t* rowp = H + (size_t)(row0 + ai * HALF + m * 16) * ldh + h0;
#pragma unroll
                for (int bj = 0; bj < 2; ++bj) { const f32x4 g = acc[ai][bj][m][0], up = acc[ai][bj][m][1]; f32x4 o;
#pragma unroll
                    for (int j = 0; j < 4; ++j) o[j] = g[j] * __builtin_amdgcn_rcpf(1.0f + __builtin_amdgcn_exp2f(-LOG2E * g[j])) * up[j];
                    u32x2 w; w.x = cvt_pk_bf16(o[0], o[1]); w.y = cvt_pk_bf16(o[2], o[3]);
                    *(u32x2*)(rowp + bj * 64) = w; } }
    }
};
struct EpiResid {
    static constexpr bool PERM = false;
    float* lat; float* ctx; const float* gates;
    __device__ __forceinline__ void operator()(const f32x4 (&acc)[2][2][4][2], const Unit& u, int wr, int wc, int fr, int fq) const {
        const int bb = u.pm < (BT / BM) ? u.pm / (T / BM) : NB;
        float* base = u.pm < (BT / BM) ? lat + (size_t)u.pm * BM * D : ctx + (size_t)(u.pm - BT / BM) * BM * D;
        const int row0 = wr * 64 + fr, col0 = u.pn * BM + wc * 32 + 4 * fq;
        const float* gp = gates + (size_t)bb * 6 * D + col0;
        f32x4 gv[2][2];
#pragma unroll
        for (int bj = 0; bj < 2; ++bj)
#pragma unroll
            for (int n = 0; n < 2; ++n) gv[bj][n] = *(const f32x4*)(gp + bj * HALF + n * 16);
        f32x4 xc[2][2], xn[2][2];
#pragma unroll
        for (int bj = 0; bj < 2; ++bj)
#pragma unroll
            for (int n = 0; n < 2; ++n) xc[bj][n] = *(const f32x4*)(base + (size_t)row0 * D + col0 + bj * HALF + n * 16);
#pragma unroll
        for (int i = 0; i < 8; ++i) { const int ai = i >> 2, m = i & 3; float* rowp = base + (size_t)(row0 + ai * HALF + m * 16) * D + col0;
            if (i < 7) { const float* nrow = base + (size_t)(row0 + ((i + 1) >> 2) * HALF + ((i + 1) & 3) * 16) * D + col0;
#pragma unroll
                for (int bj = 0; bj < 2; ++bj)
#pragma unroll
                    for (int n = 0; n < 2; ++n) xn[bj][n] = *(const f32x4*)(nrow + bj * HALF + n * 16); }
#pragma unroll
            for (int bj = 0; bj < 2; ++bj)
#pragma unroll
                for (int n = 0; n < 2; ++n) { *(f32x4*)(rowp + bj * HALF + n * 16) = xc[bj][n] + gv[bj][n] * acc[ai][bj][m][n]; xc[bj][n] = xn[bj][n]; }
            asm volatile("" ::: "memory"); }
    }
};

struct EpiDelta {
    static constexpr bool PERM = true;
    bf16_t* O; const float* gates; bf16_t* Oc;
    __device__ __forceinline__ void operator()(const f32x4 (&acc)[2][2][4][2], const Unit& u, int wr, int wc, int fr, int fq) const {
        const int bb = u.pm < (BT / BM) ? u.pm / (T / BM) : NB;
        const int row0 = u.pm * BM + wr * 64 + fr, col0 = u.pn * BM + wc * 32 + 8 * fq;
        bf16_t* Ob = u.ks > 0 ? Oc + ((long)(u.ks - 1) * BC - BT) * (long)D : O;
        const float* gp = gates + (size_t)bb * 6 * D + col0;
        f32x4 gv[2][2];
#pragma unroll
        for (int bj = 0; bj < 2; ++bj)
#pragma unroll
            for (int n = 0; n < 2; ++n) gv[bj][n] = *(const f32x4*)(gp + bj * HALF + 4 * n);
#pragma unroll
        for (int ai = 0; ai < 2; ++ai)
#pragma unroll
            for (int m = 0; m < 4; ++m) { bf16_t* rowp = Ob + (size_t)(row0 + ai * HALF + m * 16) * D + col0;
#pragma unroll
                for (int bj = 0; bj < 2; ++bj) { const f32x4 v0 = acc[ai][bj][m][0] * gv[bj][0], v1 = acc[ai][bj][m][1] * gv[bj][1];
                    u32x4 w; w.x = cvt_pk_bf16(v0[0], v0[1]); w.y = cvt_pk_bf16(v0[2], v0[3]); w.z = cvt_pk_bf16(v1[0], v1[1]); w.w = cvt_pk_bf16(v1[2], v1[3]);
                    *(u32x4*)(rowp + bj * HALF) = w; } }
    }
};
template <class Epi, class Sched, bool ALIGN_EPI = true, bool SP2 = true>
__device__ __forceinline__ void gemm_phase(PG8_LAS unsigned char* lds, const Gemm g, const Sched& S, const Epi& E, int wave_) {
    unsigned z_ = 0u; asm volatile("" : "+v"(z_)); int tid_ = (wave_ << 6) | (int)__builtin_amdgcn_mbcnt_hi(~0u, __builtin_amdgcn_mbcnt_lo(~0u, z_)); asm volatile("" : "+v"(tid_));
    static_assert(!Sched::GATHER || SP2, "row-table A loads are wired into the SP2 schedule only");
    const int tid = tid_, wid = __builtin_amdgcn_readfirstlane(tid >> 6), lane = tid & 63, wr = wid >> 2, wc = wid & 3, fr = lane & 15, fq = lane >> 4;
    const int K = g.K, nt = K / BK;
    unsigned voffA[2], voffB[2];
#pragma unroll
    for (int i = 0; i < 2; ++i) { int R, C; stage_rc(tid * 16 + i * 8192, R, C); const int Rb = Epi::PERM ? ((R & ~31) + perm32(R & 31)) : R;
        voffA[i] = (unsigned)(R * K + C) * 2u; voffB[i] = (unsigned)(Rb * K + C) * 2u; }
    const size_t kstep = (size_t)(BK * 2);
    constexpr bool GA = Sched::GATHER;
    unsigned gvo[2][2];
    PG8_LAS unsigned* gstash = (PG8_LAS unsigned*)(lds + STAGE_BYTES);
    const size_t hstep = (size_t)HALF * K * 2;
    const size_t tstep = 2 * hstep;
    const unsigned ldsw = (unsigned)wid * 1024u;
    const int aoff = lds_byte(wr * 64 + fr, fq * 8), boff = lds_byte(wc * 32 + fr, fq * 8);
#define PG8_SA(b, h) (((b) * 2 + (h)) * HTB)
#define PG8_SB(b, h) ((4 + (b) * 2 + (h)) * HTB)
#define PG8_STAGE(bufoff, gbase, voff) do { _Pragma("unroll") for (int _i = 0; _i < 2; ++_i) \
        __builtin_amdgcn_global_load_lds((const unsigned*)((const char*)(gbase) + (voff)[_i]), (PG8_LAS unsigned*)(lds + (bufoff) + ldsw + _i * 8192), 16, 0, 0); } while (0)
#define PG8_LDA(dst, b, h) do { _Pragma("unroll") for (int m = 0; m < 4; ++m) _Pragma("unroll") for (int k = 0; k < 2; ++k) dst[m][k] = *(const PG8_LAS bf16x8*)(lds + PG8_SA(b, h) + aoff + m * 2048 + k * 1024); } while (0)
#define PG8_LDB(dst, b, h) do { _Pragma("unroll") for (int n = 0; n < 2; ++n) _Pragma("unroll") for (int k = 0; k < 2; ++k) dst[n][k] = *(const PG8_LAS bf16x8*)(lds + PG8_SB(b, h) + boff + n * 2048 + k * 1024); } while (0)
#define PG8_MMA(ai, bj, At, Bt) do { __builtin_amdgcn_s_setprio(1); _Pragma("unroll") for (int m = 0; m < 4; ++m) _Pragma("unroll") for (int n = 0; n < 2; ++n) _Pragma("unroll") for (int k = 0; k < 2; ++k) \
        acc[ai][bj][m][n] = __builtin_amdgcn_mfma_f32_16x16x32_bf16(Bt[n][k], At[m][k], acc[ai][bj][m][n], 0, 0, 0); __builtin_amdgcn_s_setprio(0); } while (0)
#define PG8_WAIT_V(n) asm volatile("s_waitcnt vmcnt(" #n ")" ::: "memory")
#define PG8_WAIT_L(n) asm volatile("s_waitcnt lgkmcnt(" #n ")" ::: "memory")
#define PG8_BAR __builtin_amdgcn_s_barrier()
#define PG8_SCHED __builtin_amdgcn_sched_barrier(0)
    Unit cur, nxt; int ui = 0;
    if (!S.next(0, cur)) return;
    f32x4 acc[2][2][4][2];
#pragma unroll
    for (int a = 0; a < 2; ++a)
#pragma unroll
        for (int b = 0; b < 2; ++b)
#pragma unroll
            for (int m = 0; m < 4; ++m)
#pragma unroll
                for (int n = 0; n < 2; ++n) acc[a][b][m][n] = (f32x4){0.f, 0.f, 0.f, 0.f};
    bf16x8 At[4][2], B0[2][2], B1[2][2];
#define PG8_GDMA(u) do { _Pragma("unroll") for (int h_ = 0; h_ < 2; ++h_) _Pragma("unroll") for (int i_ = 0; i_ < 2; ++i_) { int R_, C_; stage_rc(tid * 16 + i_ * 8192, R_, C_); \
        __builtin_amdgcn_global_load_lds((const unsigned*)(S.tok + ((u).pm * BM + h_ * HALF + R_)), (PG8_LAS unsigned*)(gstash + (h_ * 2 + i_) * 512 + wid * 64), 4, 0, 0); } } while (0)
#define PG8_GREAD(o) do { _Pragma("unroll") for (int h_ = 0; h_ < 2; ++h_) _Pragma("unroll") for (int i_ = 0; i_ < 2; ++i_) { int R_, C_; stage_rc(tid * 16 + i_ * 8192, R_, C_); \
        o[h_][i_] = (gstash[(h_ * 2 + i_) * 512 + tid] * (unsigned)K + (unsigned)C_) * 2u; } } while (0)
#define PG8_STAGE_A(bufoff, ptr, h, VO) do { if constexpr (GA) { PG8_STAGE(bufoff, ptr, (VO)[h]); } else { PG8_STAGE(bufoff, (ptr) + (h) * hstep, voffA); } } while (0)
#define PG8_STAGE_AS(bufoff, ptr, h) do { if constexpr (GA) { if (last) { unsigned vs_[2]; _Pragma("unroll") for (int i_ = 0; i_ < 2; ++i_) { int R_, C_; stage_rc(tid * 16 + i_ * 8192, R_, C_); vs_[i_] = (gstash[((h) * 2 + i_) * 512 + tid] * (unsigned)K + (unsigned)C_) * 2u; } PG8_STAGE(bufoff, ptr, vs_); } \
        else { PG8_STAGE(bufoff, ptr, gvo[h]); } } else { PG8_STAGE(bufoff, (ptr) + (h) * hstep, voffA); } } while (0)
    if constexpr (GA) { PG8_GDMA(cur); PG8_WAIT_V(0); PG8_GREAD(gvo); PG8_WAIT_L(0); }
    const char* cA = (const char*)g.A + (GA ? (size_t)0 : (size_t)cur.pm * tstep); const char* cB = (const char*)g.Bt + (size_t)cur.e * g.estride + (size_t)cur.pn * tstep;
    if constexpr (Sched::KSPLIT) { cA += (size_t)cur.k0 * kstep; cB += (size_t)cur.k0 * kstep; }
    if constexpr (SP2) {
        PG8_STAGE(PG8_SB(0, 0), cB, voffB); PG8_STAGE(PG8_SB(0, 1), cB + hstep, voffB); PG8_STAGE_A(PG8_SA(0, 0), cA, 0, gvo); PG8_STAGE_A(PG8_SA(0, 1), cA, 1, gvo);
        if (wr == 1) PG8_BAR;
        PG8_WAIT_V(2); PG8_BAR;
        PG8_STAGE(PG8_SB(1, 0), cB + kstep, voffB); PG8_STAGE_A(PG8_SA(1, 0), cA + kstep, 0, gvo); PG8_STAGE(PG8_SB(1, 1), cB + hstep + kstep, voffB);
        PG8_WAIT_V(6); PG8_BAR;
    } else {
        PG8_STAGE(PG8_SB(0, 0), cB, voffB); PG8_STAGE(PG8_SA(0, 0), cA, voffA); PG8_STAGE(PG8_SB(0, 1), cB + hstep, voffB); PG8_STAGE(PG8_SA(0, 1), cA + hstep, voffA);
        if (wr == 1) PG8_BAR;
        PG8_WAIT_V(4); PG8_BAR;
        PG8_STAGE(PG8_SB(1, 0), cB + kstep, voffB); PG8_STAGE(PG8_SA(1, 0), cA + kstep, voffA); PG8_STAGE(PG8_SB(1, 1), cB + hstep + kstep, voffB);
        PG8_WAIT_V(6); PG8_BAR;
    }
    for (;;) {
        const bool has_next = S.next(ui + 1, nxt);
        if constexpr (GA) { if (has_next) PG8_GDMA(nxt); }
        const char* nA = GA ? (const char*)g.A : (has_next ? (const char*)g.A + (size_t)nxt.pm * tstep : cA); const char* nB = has_next ? (const char*)g.Bt + (size_t)nxt.e * g.estride + (size_t)nxt.pn * tstep : cB;
        if constexpr (Sched::KSPLIT) { if (has_next) { nA += (size_t)nxt.k0 * kstep; nB += (size_t)nxt.k0 * kstep; } }
        const int ntu = Sched::KSPLIT ? cur.nk : nt;
        for (int t = 0; t < ntu; t += 2) {
            const bool last = (t == ntu - 2);
            const char* a1 = cA + (size_t)(t + 1) * kstep;
            const char* a2 = last ? nA : cA + (size_t)(t + 2) * kstep; const char* b2 = last ? nB : cB + (size_t)(t + 2) * kstep;
            const char* a3 = a2 + kstep; const char* b3 = b2 + kstep;
            if constexpr (SP2) {
            PG8_LDB(B0, 0, 0); PG8_LDB(B1, 0, 1); PG8_SCHED; PG8_LDA(At, 0, 0); PG8_STAGE_A(PG8_SA(1, 1), a1, 1, gvo);
            PG8_WAIT_V(8); PG8_WAIT_L(0); PG8_BAR; PG8_MMA(0, 0, At, B0); PG8_MMA(0, 1, At, B1); PG8_BAR; PG8_SCHED;
            PG8_LDA(At, 0, 1); PG8_STAGE(PG8_SB(0, 0), b2, voffB); PG8_STAGE(PG8_SB(0, 1), b2 + hstep, voffB); PG8_STAGE_AS(PG8_SA(0, 0), a2, 0);
            PG8_WAIT_V(8); PG8_WAIT_L(0); PG8_BAR; PG8_MMA(1, 0, At, B0); PG8_MMA(1, 1, At, B1); PG8_BAR; PG8_SCHED;
            PG8_LDB(B0, 1, 0); PG8_LDB(B1, 1, 1); PG8_SCHED; PG8_LDA(At, 1, 0); PG8_STAGE_AS(PG8_SA(0, 1), a2, 1);
            PG8_WAIT_V(8); PG8_WAIT_L(0); PG8_BAR; PG8_MMA(0, 0, At, B0); PG8_MMA(0, 1, At, B1); PG8_BAR; PG8_SCHED;
            PG8_LDA(At, 1, 1); PG8_STAGE(PG8_SB(1, 0), b3, voffB); PG8_STAGE(PG8_SB(1, 1), b3 + hstep, voffB); PG8_STAGE_AS(PG8_SA(1, 0), a3, 0);
            PG8_WAIT_V(8); PG8_WAIT_L(0); PG8_BAR; PG8_MMA(1, 0, At, B0); PG8_MMA(1, 1, At, B1); PG8_BAR; PG8_SCHED;
            } else {
            PG8_LDB(B0, 0, 0); PG8_SCHED; PG8_LDA(At, 0, 0); PG8_STAGE(PG8_SA(1, 1), a1 + hstep, voffA);
            PG8_WAIT_L(8); PG8_BAR; PG8_WAIT_L(0); PG8_MMA(0, 0, At, B0); PG8_BAR; PG8_SCHED;
            PG8_LDB(B1, 0, 1); PG8_STAGE(PG8_SB(0, 0), b2, voffB);
            PG8_BAR; PG8_WAIT_L(0); PG8_MMA(0, 1, At, B1); PG8_BAR;
            PG8_LDA(At, 0, 1); PG8_STAGE(PG8_SA(0, 0), a2, voffA);
            PG8_BAR; PG8_WAIT_L(0); PG8_MMA(1, 0, At, B0); PG8_BAR; PG8_SCHED;
            PG8_STAGE(PG8_SB(0, 1), b2 + hstep, voffB);
            PG8_WAIT_V(6); PG8_BAR; PG8_MMA(1, 1, At, B1); PG8_BAR;
            PG8_LDB(B0, 1, 0); PG8_SCHED; PG8_LDA(At, 1, 0); PG8_STAGE(PG8_SA(0, 1), a2 + hstep, voffA);
            PG8_WAIT_L(8); PG8_BAR; PG8_WAIT_L(0); PG8_MMA(0, 0, At, B0); PG8_BAR; PG8_SCHED;
            PG8_LDB(B1, 1, 1); PG8_STAGE(PG8_SB(1, 0), b3, voffB);
            PG8_BAR; PG8_WAIT_L(0); PG8_MMA(0, 1, At, B1); PG8_BAR;
            PG8_LDA(At, 1, 1); PG8_STAGE(PG8_SA(1, 0), a3, voffA);
            PG8_BAR; PG8_WAIT_L(0); PG8_MMA(1, 0, At, B0); PG8_BAR; PG8_SCHED;
            PG8_STAGE(PG8_SB(1, 1), b3 + hstep, voffB);
            PG8_WAIT_V(6); PG8_BAR; PG8_MMA(1, 1, At, B1); PG8_BAR;
            }
        }
        if constexpr (ALIGN_EPI) { if (wr == 0) PG8_BAR; }
        E(acc, cur, wr, wc, fr, fq);
        if (!has_next) break;
#pragma unroll
        for (int a = 0; a < 2; ++a)
#pragma unroll
            for (int b = 0; b < 2; ++b)
#pragma unroll
                for (int m = 0; m < 4; ++m)
#pragma unroll
                    for (int n = 0; n < 2; ++n) acc[a][b][m][n] = (f32x4){0.f, 0.f, 0.f, 0.f};
        cur = nxt; cA = nA; cB = nB; ++ui;
        if constexpr (GA) { PG8_GREAD(gvo); PG8_WAIT_L(0); }
        if constexpr (ALIGN_EPI) { if (wr == 1) PG8_BAR; }
    }
    PG8_WAIT_V(0);
    if constexpr (!ALIGN_EPI) { if (wr == 0) PG8_BAR; }
    PG8_BAR;
#undef PG8_GDMA
#undef PG8_GREAD
#undef PG8_STAGE_A
#undef PG8_STAGE_AS
#undef PG8_SA
#undef PG8_SB
#undef PG8_STAGE
#undef PG8_LDA
#undef PG8_LDB
#undef PG8_MMA
#undef PG8_WAIT_V
#undef PG8_WAIT_L
#undef PG8_BAR
#undef PG8_SCHED
}
}

__device__ __forceinline__ int tid_of_wave(int wave) { unsigned z = 0u; asm volatile("" : "+v"(z)); return (wave << 6) | (int)__builtin_amdgcn_mbcnt_hi(~0u, __builtin_amdgcn_mbcnt_lo(~0u, z)); }
#define XB_TMO      128
#define XB_XCNT(j)  (256  + 64 * (j))
#define XB_XSUB(j)  (1280 + 64 * (j))
#define XB_XGEN(j)  (2304 + 64 * (j))
#define XB_TOP      3328
#define XB_TOPGEN   3392
#define XCD_BAR_WORDS 3456
#define XB_SPIN_CAP (1u << 18)
__device__ __forceinline__ unsigned xb_ld(unsigned* p)              { return __hip_atomic_load(p, __ATOMIC_RELAXED, __HIP_MEMORY_SCOPE_AGENT); }
__device__ __forceinline__ unsigned xb_add(unsigned* p, unsigned v) { return __hip_atomic_fetch_add(p, v, __ATOMIC_RELAXED, __HIP_MEMORY_SCOPE_AGENT); }
__device__ __forceinline__ unsigned xb_xcc_id() { return (unsigned)__builtin_amdgcn_s_getreg((3 << 11) | 20) & 0xFu; }
#define XB_SPIN(cond, bar) do { unsigned _sp = 0; while (cond) { __builtin_amdgcn_s_sleep(1); \
    if ((++_sp & 255u) == 0u) { if (xb_ld(&(bar)[XB_TMO])) break; if (_sp > XB_SPIN_CAP) { atomicAdd(&(bar)[XB_TMO], 1u); break; } } } } while (0)
struct XcdBarrier { unsigned* bar; unsigned x; volatile LAS unsigned* st; };
__device__ __forceinline__ XcdBarrier xcd_barrier_post(unsigned* bar, volatile LAS unsigned* st) {
    XcdBarrier b; b.bar = bar; b.x = xb_xcc_id(); b.st = st;
    if (threadIdx.x == 0) (void)xb_add(&bar[XB_XCNT(b.x)], 1u);
    return b;
}
__device__ __forceinline__ void xcd_barrier_complete(unsigned* bar, unsigned x, unsigned& nloc, unsigned& nx) {
    const unsigned G = gridDim.x * gridDim.y * gridDim.z;
    unsigned sum, cnt, mine, sp = 0u;
    for (;;) {
        sum = 0u; cnt = 0u; mine = 0u;
#pragma unroll
        for (unsigned j = 0; j < 16; ++j) { const unsigned c = xb_ld(&bar[XB_XCNT(j)]); sum += c; cnt += (c > 0u) ? 1u : 0u; mine = (j == x) ? c : mine; }
        if (sum == G) break;
        __builtin_amdgcn_s_sleep(1);
        if ((++sp & 255u) == 0u) { if (xb_ld(&bar[XB_TMO])) break; if (sp > XB_SPIN_CAP) { atomicAdd(&bar[XB_TMO], 1u); break; } }
    }
    nloc = mine > 0u ? mine : 1u; nx = cnt > 0u ? cnt : 1u;
}
__device__ __forceinline__ void xcd_barrier(const XcdBarrier& b, int wave) {
    asm volatile("s_waitcnt vmcnt(0)" ::: "memory");
    __syncthreads();
    if (tid_of_wave(wave) == 0) {
        unsigned* bar = b.bar;
        __builtin_amdgcn_s_waitcnt(0);
        unsigned nloc = b.st[0], nx = b.st[1];
        if (nloc == 0u) { xcd_barrier_complete(bar, b.x, nloc, nx); b.st[0] = nloc; b.st[1] = nx; }
        const unsigned old = xb_add(&bar[XB_XSUB(b.x)], 1u);
        const unsigned gen = old / nloc;
        if (old + 1u == (gen + 1u) * nloc) {
            __builtin_amdgcn_fence(__ATOMIC_RELEASE, "agent");
            asm volatile("s_waitcnt vmcnt(0)" ::: "memory");
            const unsigned og = xb_add(&bar[XB_TOP], 1u);
            const unsigned tg = og / nx;
            if (og + 1u == (tg + 1u) * nx) xb_add(&bar[XB_TOPGEN], 1u);
            else XB_SPIN(xb_ld(&bar[XB_TOPGEN]) == tg, bar);
            __builtin_amdgcn_fence(__ATOMIC_ACQUIRE, "agent");
            xb_add(&bar[XB_XGEN(b.x)], 1u);
            asm volatile("s_waitcnt vmcnt(0)" ::: "memory");
        } else {
            XB_SPIN(xb_ld(&bar[XB_XGEN(b.x)]) == gen, bar);
            __builtin_amdgcn_fence(__ATOMIC_ACQUIRE, "agent");
            asm volatile("s_waitcnt vmcnt(0)" ::: "memory");
        }
    }
    __syncthreads();
}

constexpr int NWAVES = 8, NTHR = 512;
constexpr int RING_BYTES = 131072, LDS_BYTES = 147456, MISC_OFF = LDS_BYTES - 256;
struct Args { const float* in[37]; float* out; unsigned char* ws; int s_lo, s_hi; };
enum { I_X = 0, I_C, I_CTX, I_CCTX, I_WADA, I_BADA, I_WIN, I_WOUT, I_LN1G, I_LN1B, I_LN2G, I_LN2B, I_LQ1, I_LK1, I_LQ2, I_LK2, I_SUBLN, I_RKVCONV, I_DW0, I_DUP, I_A0, I_AUP,
       I_GUP, I_KK, I_KA, I_RK, I_GNG, I_GNB, I_CONVW, I_FW1, I_FW3, I_FW2, I_RW, I_RB, I_MW1, I_MW3, I_MW2 };

struct Frame {
    LAS unsigned char* lds;
    unsigned* ctl;
    int tid, lane, wave, G, bid;
    const float* const* in; float* out; unsigned char* ws;
};
__device__ __forceinline__ float* xs_row(const Frame& F, int row) { return row < BT ? F.out + (size_t)row * D : (float*)(F.ws + WS_XSC) + (size_t)(row - BT) * D; }
__device__ __forceinline__ const float* mods_ptr(const Frame& F, int l, int bb, int idx) { return (const float*)(F.ws + WS_MODS) + ((size_t)(l * 9 + bb) * 6 + idx) * D; }

__device__ __forceinline__ Frame fresh(const Frame& F0) { Frame F = F0; int t = tid_of_wave(F0.wave); asm volatile("" : "+v"(t)); F.tid = t; F.lane = t & 63; return F; }

__device__ __forceinline__ void ph_mods(const Frame& F0, int l_lo, int l_hi, int vbid, int vG) {
    const Frame F = fresh(F0);
    LAS float* sc = (LAS float*)F.lds;
    LAS float* red = (LAS float*)(F.lds + 9 * 1024 * 4);
    const float* c = F.in[I_C]; const float* cc = F.in[I_CCTX];
    for (int i = F.tid; i < 9 * D; i += NTHR) { const float v = i < NB * D ? c[i] : cc[i - NB * D]; sc[i] = v / (1.0f + __expf(-v)); }
    __syncthreads();
    const int jgsub = F.wave >> 2, kq = F.wave & 3;
    for (int wi = vbid; wi < ((l_hi - l_lo) * 6 * D) / 128; wi += vG) {
        const int it = wi * 128 + jgsub * 64 + F.lane, l = l_lo + it / (6 * D), j = it % (6 * D);
        const float* w = F.in[I_WADA] + (size_t)l * D * 6 * D + j;
        float acc[9];
#pragma unroll
        for (int b = 0; b < 9; ++b) acc[b] = 0.f;
        for (int k0 = kq * 256; k0 < kq * 256 + 256; k0 += 16) { float wv[16];
#pragma unroll
            for (int u = 0; u < 16; ++u) wv[u] = w[(size_t)(k0 + u) * 6 * D];
#pragma unroll
            for (int u = 0; u < 16; ++u)
#pragma unroll
                for (int b = 0; b < 9; ++b) acc[b] += sc[b * D + k0 + u] * wv[u]; }
#pragma unroll
        for (int b = 0; b < 9; ++b) red[(F.wave * 9 + b) * 64 + F.lane] = acc[b];
        __syncthreads();
        if (kq == 0) {
            const float bias = F.in[I_BADA][l * 6 * D + j];
#pragma unroll
            for (int b = 0; b < 9; ++b) { const float s = red[((F.wave + 0) * 9 + b) * 64 + F.lane] + red[((F.wave + 1) * 9 + b) * 64 + F.lane] + red[((F.wave + 2) * 9 + b) * 64 + F.lane] + red[((F.wave + 3) * 9 + b) * 64 + F.lane];
                ((float*)(F.ws + WS_MODS))[(size_t)(l * 9 + b) * 6 * D + j] = s + bias; }
        }
        __syncthreads();
    }
    if (l_lo == 0 && vbid == 0 && F.tid < DEPTH) {
        const int l = F.tid; float s1 = 0.f, s2 = 0.f;
        for (int i = 0; i < 64; ++i) { s1 += F.in[I_LQ1][l * 64 + i] * F.in[I_LK1][l * 64 + i]; s2 += F.in[I_LQ2][l * 64 + i] * F.in[I_LK2][l * 64 + i]; }
        const float lam_init = 0.8f - 0.6f * expf(-0.3f * (float)l);
        ((float*)(F.ws + WS_LAM))[l] = expf(s1) - expf(s2) + lam_init;
    }
}

__device__ __forceinline__ void transpose_item(const float* W, int K, int N, bf16_t* WT, int kind, LAS float* scr, int item, int lane) {
    const int nblk = N / 32, kb = item / nblk, nb = item % nblk, k0 = 64 * kb, n0 = 32 * nb;
    f32x4 wv[8];
#pragma unroll
    for (int i = 0; i < 8; ++i) wv[i] = __builtin_nontemporal_load((const f32x4*)(W + (size_t)(k0 + i * 8 + (lane >> 3)) * N + n0 + 4 * (lane & 7)));
#pragma unroll
    for (int i = 0; i < 8; ++i) { LAS float* d = scr + (i * 8 + (lane >> 3)) * 33 + 4 * (lane & 7); d[0] = wv[i][0]; d[1] = wv[i][1]; d[2] = wv[i][2]; d[3] = wv[i][3]; }
    asm volatile("s_waitcnt lgkmcnt(0)" ::: "memory");
    const int c = lane & 7;
#pragma unroll
    for (int j = 0; j < 4; ++j) { const int n = (lane >> 3) + 8 * j; const LAS float* s = scr + (8 * c) * 33 + n;
        u32x4 o; o.x = pk2(s[0 * 33], s[1 * 33]); o.y = pk2(s[2 * 33], s[3 * 33]); o.z = pk2(s[4 * 33], s[5 * 33]); o.w = pk2(s[6 * 33], s[7 * 33]);
        const int ng = n0 + n; const int row = kind == 0 ? ng : ((ng >> 2) * 8 + (ng & 3) + (kind == 2 ? 4 : 0));
        *(u32x4*)(WT + (size_t)row * K + k0 + 8 * c) = o; }
    asm volatile("s_waitcnt lgkmcnt(0)" ::: "memory");
}
__device__ __forceinline__ void ph_convert(const Frame& F0, int l, int part, int vbid, int vG) {
    const Frame F = fresh(F0);
    if (part == 0) {
        const float* dup = F.in[I_DUP] + (size_t)l * 2 * 32 * 256; const float* aup = F.in[I_AUP] + (size_t)l * 2 * 32 * 256; const float* gup = F.in[I_GUP] + (size_t)l * 64 * 256;
        for (int p = vbid * NTHR + F.tid; p < 6 * 16 * 64; p += vG * NTHR) { const int ln = p & 63, ct = (p >> 6) & 15, win = p >> 10, m = ln & 15, g = ln >> 4, c = ct * 16 + m;
            const float* src = win < 2 ? dup + (size_t)win * 32 * 256 : (win < 4 ? aup + (size_t)(win - 2) * 32 * 256 : gup + (size_t)(win - 4) * 32 * 256);
            u32x4 w;
#pragma unroll
            for (int i = 0; i < 4; ++i) w[i] = pk2(src[(8 * g + 2 * i) * 256 + c], src[(8 * g + 2 * i + 1) * 256 + c]);
            *(u32x4*)(F.ws + WS_LW + (size_t)p * 16) = w; }
    }
    LAS float* scr = (LAS float*)(F.lds + 57344 + F.wave * 8704);
    const int gw = vbid * NWAVES + F.wave, NGW = vG * NWAVES;
    constexpr int I_IN = (D / 64) * (NPROJ / 32), I_OUT = (D / 64) * (D / 32);
    const int j = l >> 1;
    if ((l & 1) == 0) {
        constexpr int I_13 = (D / 64) * (DFF / 32), I_2 = (DFF / 64) * (D / 32);
        for (int it = gw + (part ? I_IN + I_OUT : 0); it < (part ? I_IN + I_OUT + 2 * I_13 + I_2 : I_IN + I_OUT); it += NGW) {
            int r = it;
            if (r < I_IN) { transpose_item(F.in[I_WIN] + (size_t)l * D * NPROJ, D, NPROJ, (bf16_t*)(F.ws + WS_WIN), 0, scr, r, F.lane); continue; } r -= I_IN;
            if (r < I_OUT) { transpose_item(F.in[I_WOUT] + (size_t)l * D * D, D, D, (bf16_t*)(F.ws + WS_WOUT), 0, scr, r, F.lane); continue; } r -= I_OUT;
            if (r < I_13) { transpose_item(F.in[I_FW1] + (size_t)j * D * DFF, D, DFF, (bf16_t*)(F.ws + WS_WFF), 1, scr, r, F.lane); continue; } r -= I_13;
            if (r < I_13) { transpose_item(F.in[I_FW3] + (size_t)j * D * DFF, D, DFF, (bf16_t*)(F.ws + WS_WFF), 2, scr, r, F.lane); continue; } r -= I_13;
            transpose_item(F.in[I_FW2] + (size_t)j * DFF * D, DFF, D, (bf16_t*)(F.ws + WS_WFF2), 0, scr, r, F.lane);
        }
    } else {
        constexpr int I_13 = (D / 64) * (DFFE / 32), I_2 = (DFFE / 64) * (D / 32);
        for (int it = gw + (part ? I_IN + I_OUT : 0); it < (part ? I_IN + I_OUT + NE * (2 * I_13 + I_2) : I_IN + I_OUT); it += NGW) {
            int r = it;
            if (r < I_IN) { transpose_item(F.in[I_WIN] + (size_t)l * D * NPROJ, D, NPROJ, (bf16_t*)(F.ws + WS_WIN), 0, scr, r, F.lane); continue; } r -= I_IN;
            if (r < I_OUT) { transpose_item(F.in[I_WOUT] + (size_t)l * D * D, D, D, (bf16_t*)(F.ws + WS_WOUT), 0, scr, r, F.lane); continue; } r -= I_OUT;
            const int e = r / (2 * I_13 + I_2); r -= e * (2 * I_13 + I_2);
            const size_t eo = (size_t)(j * NE + e);
            if (r < I_13) { transpose_item(F.in[I_MW1] + eo * D * DFFE, D, DFFE, (bf16_t*)(F.ws + WS_WFF) + (size_t)e * 2 * DFFE * D, 1, scr, r, F.lane); continue; } r -= I_13;
            if (r < I_13) { transpose_item(F.in[I_MW3] + eo * D * DFFE, D, DFFE, (bf16_t*)(F.ws + WS_WFF) + (size_t)e * 2 * DFFE * D, 2, scr, r, F.lane); continue; } r -= I_13;
            transpose_item(F.in[I_MW2] + eo * DFFE * D, DFFE, D, (bf16_t*)(F.ws + WS_WFF2) + (size_t)e * D * DFFE, 0, scr, r, F.lane);
        }
    }
}

template <int MODE>
__device__ __forceinline__ void ph_ln(const Frame& F0, int l, bool dry = false) {
    const Frame F = fresh(F0);
    constexpr int R = 4;
    const int gw = F.bid * NWAVES + F.wave, NGW = F.G * NWAVES;
    const int nrows = (MODE == 0 || l < DEPTH - 1) ? M : BT;
    const bool moe = (l & 1) != 0;
    const float* lg = F.in[MODE == 1 ? I_LN1G : I_LN2G] + l * D; const float* lb = F.in[MODE == 1 ? I_LN1B : I_LN2B] + l * D;
    const int lm = MODE == 2 ? l + 1 : l, si = MODE == 1 ? 3 : 0;
    bf16_t* ACT = (bf16_t*)(F.ws + WS_ACT);
    const int co = 4 * F.lane;
    for (int grp = gw; grp < nrows / R; grp += NGW) {
        const int row0 = grp * R, bb = row0 < BT ? row0 / T : NB;
        f32x4 v[R][4];
#pragma unroll
        for (int r = 0; r < R; ++r) { const int row = row0 + r;
            const bool fromin = MODE == 0 || (MODE == 1 && l == 0);
            const float* src = fromin ? (row < BT ? F.in[I_X] + (size_t)row * D : F.in[I_CTX] + (size_t)(row - BT) * D) : xs_row(F, row);
#pragma unroll
            for (int j = 0; j < 4; ++j) { v[r][j] = __builtin_nontemporal_load((const f32x4*)(src + co + 256 * j)); if (MODE == 1 && l == 0) v[r][j] = v[r][j] * DN_ALPHA; } }
        if (MODE == 1 || (MODE == 2 && !moe)) {
            const bf16_t* dl = (const bf16_t*)(F.ws + (MODE == 1 ? WS_R1 : WS_R2)) + (size_t)row0 * D + co;
            u32x2 dv[R][4];
#pragma unroll
            for (int r = 0; r < R; ++r)
#pragma unroll
                for (int j = 0; j < 4; ++j) dv[r][j] = __builtin_nontemporal_load((const u32x2*)(dl + (size_t)r * D + 256 * j));
#pragma unroll
            for (int r = 0; r < R; ++r)
#pragma unroll
                for (int j = 0; j < 4; ++j) { v[r][j][0] += bflo(dv[r][j].x); v[r][j][1] += bfhi(dv[r][j].x); v[r][j][2] += bflo(dv[r][j].y); v[r][j][3] += bfhi(dv[r][j].y); }
            if (row0 >= BT) {
                const int ns = MODE == 1 ? 4 : 2;
                for (int ks = 1; ks < ns; ++ks) { const bf16_t* pl = (const bf16_t*)(F.ws + (MODE == 1 ? WS_R1 : WS_R2) + 68 * MiB) + ((size_t)(ks - 1) * BC + (row0 - BT)) * D + co;
#pragma unroll
                    for (int r = 0; r < R; ++r)
#pragma unroll
                        for (int j = 0; j < 4; ++j) { const u32x2 x = *(const u32x2*)(pl + (size_t)r * D + 256 * j); v[r][j][0] += bflo(x.x); v[r][j][1] += bfhi(x.x); v[r][j][2] += bflo(x.y); v[r][j][3] += bfhi(x.y); } }
            }
        }
        if (MODE == 2 && moe) {
            const float* gate = mods_ptr(F, l, bb, 5);
            f32x4 gt[4];
#pragma unroll
            for (int j = 0; j < 4; ++j) gt[j] = *(const f32x4*)(gate + co + 256 * j);
            f32x2 tg[R]; int2 sl[R];
#pragma unroll
            for (int r = 0; r < R; ++r) { tg[r] = ((const f32x2*)(F.ws + WS_TOPG))[row0 + r]; sl[r] = ((const int2*)(F.ws + WS_SLOT))[row0 + r]; }
            u32x2 oa[R][4], ob[R][4];
#pragma unroll
            for (int r = 0; r < R; ++r) { const bf16_t* o0 = (const bf16_t*)(F.ws + WS_R2) + (size_t)sl[r].x * D, * o1 = (const bf16_t*)(F.ws + WS_R2) + (size_t)sl[r].y * D;
#pragma unroll
                for (int j = 0; j < 4; ++j) { oa[r][j] = __builtin_nontemporal_load((const u32x2*)(o0 + co + 256 * j)); ob[r][j] = __builtin_nontemporal_load((const u32x2*)(o1 + co + 256 * j)); } }
#pragma unroll
            for (int r = 0; r < R; ++r)
#pragma unroll
                for (int j = 0; j < 4; ++j) { const u32x2 a = oa[r][j], b = ob[r][j];
                    v[r][j][0] += gt[j][0] * (tg[r].x * bflo(a.x) + tg[r].y * bflo(b.x)); v[r][j][1] += gt[j][1] * (tg[r].x * bfhi(a.x) + tg[r].y * bfhi(b.x));
                    v[r][j][2] += gt[j][2] * (tg[r].x * bflo(a.y) + tg[r].y * bflo(b.y)); v[r][j][3] += gt[j][3] * (tg[r].x * bfhi(a.y) + tg[r].y * bfhi(b.y)); }
        }
        if (MODE != 0) {
            f32x4 g4[4], b4[4];
#pragma unroll
            for (int j = 0; j < 4; ++j) { g4[j] = *(const f32x4*)(lg + co + 256 * j); b4[j] = *(const f32x4*)(lb + co + 256 * j); }
            float s1[R], s2[R];
#pragma unroll
            for (int r = 0; r < R; ++r) { float a = 0.f, q = 0.f;
#pragma unroll
                for (int j = 0; j < 4; ++j) { a += (v[r][j][0] + v[r][j][1]) + (v[r][j][2] + v[r][j][3]); q += (v[r][j][0] * v[r][j][0] + v[r][j][1] * v[r][j][1]) + (v[r][j][2] * v[r][j][2] + v[r][j][3] * v[r][j][3]); }
                s1[r] = a; s2[r] = q; }
#pragma unroll
            for (int r = 0; r < R; ++r) { s1[r] = wave_sum(s1[r]); s2[r] = wave_sum(s2[r]); }
#pragma unroll
            for (int r = 0; r < R; ++r) { const float mean = s1[r] * (1.0f / D); const float var = fmaxf(s2[r] * (1.0f / D) - mean * mean, 0.f); const float rstd = 1.0f / sqrtf(var + LN_EPS);
#pragma unroll
                for (int j = 0; j < 4; ++j) v[r][j] = (v[r][j] - mean) * rstd * g4[j] + b4[j]; }
        }
        if (MODE == 2 && l == DEPTH - 1) {
#pragma unroll
            for (int r = 0; r < R; ++r) { float* dst = F.out + (size_t)(row0 + r) * D;
#pragma unroll
                for (int j = 0; j < 4; ++j) if (!dry) *(f32x4*)(dst + co + 256 * j) = v[r][j]; }
            continue;
        }
        const float* sh = mods_ptr(F, lm, bb, si); const float* scl = mods_ptr(F, lm, bb, si + 1);
        f32x4 sh4[4], sc4[4];
#pragma unroll
        for (int j = 0; j < 4; ++j) { sh4[j] = *(const f32x4*)(sh + co + 256 * j); sc4[j] = *(const f32x4*)(scl + co + 256 * j) + 1.0f; }
#pragma unroll
        for (int r = 0; r < R; ++r) { float* dst = xs_row(F, row0 + r);
#pragma unroll
            for (int j = 0; j < 4; ++j) { if (!dry && MODE != 0) __builtin_nontemporal_store(v[r][j] * DN_ALPHA, (f32x4*)(dst + co + 256 * j)); v[r][j] = v[r][j] * sc4[j] + sh4[j];
                u32x2 w; w.x = cvtpk(v[r][j][0], v[r][j][1]); w.y = cvtpk(v[r][j][2], v[r][j][3]); *(u32x2*)(ACT + (size_t)(row0 + r) * D + co + 256 * j) = w; } }
        if (MODE == 1 && moe) {
            const int jl = l >> 1; const float* rw = F.in[I_RW] + (size_t)jl * D * NE;
            float lg8[R][NE];
#pragma unroll
            for (int r = 0; r < R; ++r)
#pragma unroll
                for (int e = 0; e < NE; ++e) lg8[r][e] = 0.f;
#pragma unroll
            for (int j = 0; j < 4; ++j)
#pragma unroll
                for (int i = 0; i < 4; ++i) { const int k = co + 256 * j + i; const f32x4 w0 = *(const f32x4*)(rw + (size_t)k * NE), w1 = *(const f32x4*)(rw + (size_t)k * NE + 4);
#pragma unroll
                    for (int r = 0; r < R; ++r) { const float hv = v[r][j][i];
                        lg8[r][0] += hv * w0[0]; lg8[r][1] += hv * w0[1]; lg8[r][2] += hv * w0[2]; lg8[r][3] += hv * w0[3]; lg8[r][4] += hv * w1[0]; lg8[r][5] += hv * w1[1]; lg8[r][6] += hv * w1[2]; lg8[r][7] += hv * w1[3]; } }
#pragma unroll
            for (int r = 0; r < R; ++r)
#pragma unroll
                for (int e = 0; e < NE; ++e) lg8[r][e] = wave_sum(lg8[r][e]) + F.in[I_RB][jl * NE + e];
#pragma unroll
            for (int r = 0; r < R; ++r) {
                int e0 = 0; float l0 = lg8[r][0];
#pragma unroll
                for (int e = 1; e < NE; ++e) if (lg8[r][e] > l0) { l0 = lg8[r][e]; e0 = e; }
                int e1 = -1; float l1 = -3.0e38f;
#pragma unroll
                for (int e = 0; e < NE; ++e) if (e != e0 && lg8[r][e] > l1) { l1 = lg8[r][e]; e1 = e; }
                const float g0 = 1.0f / (1.0f + __expf(l1 - l0));
                if (!dry && F.lane == 2 * r) { ((unsigned*)(F.ws + WS_TOPE))[row0 + r] = (unsigned)e0 | ((unsigned)e1 << 8); ((f32x2*)(F.ws + WS_TOPG))[row0 + r] = (f32x2){g0, 1.0f - g0}; atomicAdd(F.ctl + CW_CNT + 64 * jl + e0, 1u); }
                if (!dry && F.lane == 2 * r + 1) atomicAdd(F.ctl + CW_CNT + 64 * jl + e1, 1u);
            }
        }
    }
}

__device__ __forceinline__ void ph_moe_gather(const Frame& F0, int l) {
    const Frame F = fresh(F0);
    constexpr int R = 4;
    const int jl = l >> 1, nrows = l < DEPTH - 1 ? M : BT;
    int mybase = 0; { int t = 0;
#pragma unroll
        for (int e = 0; e < NE; ++e) { mybase = (F.lane == e) ? t : mybase; t += (int)(((__hip_atomic_load(F.ctl + CW_CNT + 64 * jl + e, __ATOMIC_RELAXED, __HIP_MEMORY_SCOPE_AGENT) + 255u) >> 8) << 8); } }
    int* TOK = (int*)(F.ws + WS_TOK);
    if (F.bid == 0) {
        for (int e = 0; e < NE; ++e) { const int cnt = (int)__hip_atomic_load(F.ctl + CW_CNT + 64 * jl + e, __ATOMIC_RELAXED, __HIP_MEMORY_SCOPE_AGENT), base = __shfl(mybase, e);
            for (int p = cnt + F.tid; p < ((cnt + 255) & ~255); p += NTHR) TOK[base + p] = 0; } }
    for (int grp = F.bid * NWAVES + F.wave; grp < nrows / R; grp += F.G * NWAVES) {
        const int row0 = grp * R;
        int slot = 0;
        { const unsigned te = ((const unsigned*)(F.ws + WS_TOPE))[row0 + ((F.lane >> 1) & (R - 1))]; const int e = ((F.lane & 1) ? (te >> 8) : te) & 7;
          const int bsel = __shfl(mybase, e);
          if (F.lane < 2 * R) slot = bsel + (int)atomicAdd(F.ctl + CW_CUR + 64 * jl + e, 1u); }
#pragma unroll
        for (int r = 0; r < R; ++r) { const int s0 = __shfl(slot, 2 * r), s1 = __shfl(slot, 2 * r + 1);
            if (F.lane == 0) { ((int2*)(F.ws + WS_SLOT))[row0 + r] = make_int2(s0, s1); TOK[s0] = row0 + r; TOK[s1] = row0 + r; } }
    }
}

constexpr int ATT_TILEB = 32768, NT_LAT = (CT + T) / 64, NT_CTX = CT / 64;
constexpr float QSCALE = 0.125f * LOG2E;
__device__ __forceinline__ float fast_tanh(float x) { const float e = __builtin_amdgcn_exp2f(2.0f * LOG2E * x); return 1.0f - 2.0f * __builtin_amdgcn_rcpf(e + 1.0f); }
__device__ __forceinline__ void ph_prep1(const Frame& F0, int l, bool writeq) {
    const Frame F = fresh(F0);
    bf16_t* QKV = (bf16_t*)(F.ws + WS_QKV);
    unsigned char* KV = F.ws + WS_KV;
    {
        LAS f32x2* ROPE = (LAS f32x2*)F.lds;
        LAS bf16_t* VS = (LAS bf16_t*)(F.lds + 8192);
        for (int i = F.tid; i < 1024; i += NTHR) { const int pos = i >> 4, j = i & 15; const float ang = (float)pos * exp2f(-(float)j * (13.287712379549449f / 16.0f)); ROPE[i] = (f32x2){__cosf(ang), __sinf(ang)}; }
        const int tok = F.tid >> 5, sub = F.tid & 31, hm = sub >> 2, ax = (sub >> 1) & 1, chunk = sub & 1;
        struct P1In { u32x4 v0, v1, qa, qb, ka, kb; };
        auto p1load = [&](int u, P1In& x) { const int row0 = u * 16; const bf16_t* px = QKV + (size_t)(row0 + tok) * LDQ + hm * 64 + ax * 32 + chunk * 8;
            x.v0 = __builtin_nontemporal_load((const u32x4*)(QKV + (size_t)(row0 + (F.tid >> 6)) * LDQ + OV + 8 * (F.tid & 63))); x.v1 = __builtin_nontemporal_load((const u32x4*)(QKV + (size_t)(row0 + 8 + (F.tid >> 6)) * LDQ + OV + 8 * (F.tid & 63)));
            x.qa = __builtin_nontemporal_load((const u32x4*)(px + OQ)); x.qb = __builtin_nontemporal_load((const u32x4*)(px + OQ + 16)); x.ka = __builtin_nontemporal_load((const u32x4*)(px + OK_)); x.kb = __builtin_nontemporal_load((const u32x4*)(px + OK_ + 16)); };
        P1In cur, nxt;
        if (F.bid < M / 16) p1load(F.bid, cur);
        for (int u = F.bid; u < M / 16; u += F.G) {
            const int row0 = u * 16; const bool lat = row0 < BT; const int t0 = lat ? (row0 % T) : ((row0 - BT) % CT);
            const int b = lat ? row0 / T : (row0 - BT) / CT, kb = lat ? CT + t0 : t0, tile = kb >> 6, jq = (kb >> 4) & 3;
            if (u + F.G < M / 16) p1load(u + F.G, nxt);
            __syncthreads();
            const int row = row0 + tok, t = t0 + tok, pos = ax == 0 ? t / GW : t % GW;
            bf16_t* px = QKV + (size_t)row * LDQ;
            *(LAS u32x4*)(VS + (F.tid >> 6) * 512 + 8 * (F.tid & 63)) = cur.v0; *(LAS u32x4*)(VS + (8 + (F.tid >> 6)) * 512 + 8 * (F.tid & 63)) = cur.v1;
            f32x2 cs[8];
#pragma unroll
            for (int e = 0; e < 8; ++e) cs[e] = lat ? ROPE[pos * 16 + chunk * 8 + e] : (f32x2){1.0f, 0.f};
#pragma unroll
            for (int w = 0; w < 2; ++w) {
                bf16_t* p1 = px + (w ? OK_ : OQ) + hm * 64 + ax * 32 + chunk * 8; const u32x4 a = w ? cur.ka : cur.qa, bq = w ? cur.kb : cur.qb;
                u32x4 o1, o2; const float sc = w ? 1.0f : QSCALE;
#pragma unroll
                for (int e = 0; e < 4; ++e) { const float x1l = bflo(a[e]), x1h = bfhi(a[e]), x2l = bflo(bq[e]), x2h = bfhi(bq[e]); const f32x2 c0 = cs[2 * e], c1 = cs[2 * e + 1];
                    o1[e] = cvtpk((x1l * c0.x - x2l * c0.y) * sc, (x1h * c1.x - x2h * c1.y) * sc); o2[e] = cvtpk((x2l * c0.x + x1l * c0.y) * sc, (x2h * c1.x + x1h * c1.y) * sc); }
                if (w == 0) { if (writeq) { *(u32x4*)p1 = o1; *(u32x4*)(p1 + 16) = o2; } }
                else { unsigned char* timg = KV + ((size_t)(b * 4 + (hm >> 1)) * NT_LAT + tile) * ATT_TILEB + (hm & 1) * 8192 + (jq * 16 + tok) * 16;
                    *(u32x4*)(timg + ((ax * 2 + 0) * 2 + chunk) * 1024) = o1; *(u32x4*)(timg + ((ax * 2 + 1) * 2 + chunk) * 1024) = o2; }
            }
            __syncthreads();
#pragma unroll
            for (int pi = 0; pi < 2; ++pi) { const int p = F.tid + pi * NTHR, hh = p >> 8, dl = p & 31, kg = (p >> 5) & 1, dt = (p >> 6) & 3;
                const LAS bf16_t* vs = VS + hh * 128 + 32 * dt + dl + (4 * kg) * 512;
                u32x4 w; w.x = (unsigned)vs[0 * 512] | ((unsigned)vs[1 * 512] << 16); w.y = (unsigned)vs[2 * 512] | ((unsigned)vs[3 * 512] << 16);
                w.z = (unsigned)vs[8 * 512] | ((unsigned)vs[9 * 512] << 16); w.w = (unsigned)vs[10 * 512] | ((unsigned)vs[11 * 512] << 16);
                *(u32x4*)(KV + ((size_t)(b * 4 + hh) * NT_LAT + tile) * ATT_TILEB + 16384 + (((dt * 4 + jq) * 2 + kg) * 32 + dl) * 16) = w; }
            cur = nxt;
        }
    }
}
__device__ __forceinline__ void ph_prep2(const Frame& F0, int l) {
    const Frame F = fresh(F0);
    const bf16_t* REST = (const bf16_t*)(F.ws + WS_REST); bf16_t* MIX = (bf16_t*)(F.ws + WS_ACT);
    {
        const float* cw = F.in[I_CONVW] + (size_t)l * 3 * 256;
        const int tok = F.tid >> 5, c8 = (F.tid & 31) * 8;
        f32x4 w3[3][2];
#pragma unroll
        for (int j = 0; j < 3; ++j) { w3[j][0] = *(const f32x4*)(cw + j * 256 + c8); w3[j][1] = *(const f32x4*)(cw + j * 256 + c8 + 4); }
        struct P2In { u32x4 hc, cc, cb, hmv, cmv, hpv, cpv; };
        auto p2load = [&](int u, P2In& x) {
            const int row0 = u * 16; const bool lat = row0 < BT; const int tseq = lat ? T : CT, t = (lat ? (row0 % T) : ((row0 - BT) % CT)) + tok, row = row0 + tok;
            const bf16_t* pc = REST + (size_t)row * LDR; const bool hm_ = t > 0, hp_ = t + 1 < tseq; const bf16_t* pm = hm_ ? pc - LDR : pc; const bf16_t* pp = hp_ ? pc + LDR : pc;
            const unsigned mkm = hm_ ? 0xffffffffu : 0u, mkp = hp_ ? 0xffffffffu : 0u;
            x.hc = __builtin_nontemporal_load((const u32x4*)(pc + OCH + c8)); x.cc = __builtin_nontemporal_load((const u32x4*)(pc + OCC + c8)); x.cb = __builtin_nontemporal_load((const u32x4*)(pc + OCB + c8));
            x.hmv = *(const u32x4*)(pm + OCH + c8) & mkm; x.cmv = *(const u32x4*)(pm + OCC + c8); x.hpv = *(const u32x4*)(pp + OCH + c8) & mkp; x.cpv = *(const u32x4*)(pp + OCC + c8); };
        P2In cur, nxt;
        if (F.bid < M / 16) p2load(F.bid, cur);
        for (int u = F.bid; u < M / 16; u += F.G) {
            if (u + F.G < M / 16) p2load(u + F.G, nxt);
            const int row = u * 16 + tok;
            u32x4 o;
#pragma unroll
            for (int e = 0; e < 4; ++e) {
                const float lo = bflo(cur.cb[e]) * (w3[0][e >> 1][2 * (e & 1)] * bflo(cur.hmv[e]) * bflo(cur.cmv[e]) + w3[1][e >> 1][2 * (e & 1)] * bflo(cur.hc[e]) * bflo(cur.cc[e]) + w3[2][e >> 1][2 * (e & 1)] * bflo(cur.hpv[e]) * bflo(cur.cpv[e]));
                const float hi = bfhi(cur.cb[e]) * (w3[0][e >> 1][2 * (e & 1) + 1] * bfhi(cur.hmv[e]) * bfhi(cur.cmv[e]) + w3[1][e >> 1][2 * (e & 1) + 1] * bfhi(cur.hc[e]) * bfhi(cur.cc[e]) + w3[2][e >> 1][2 * (e & 1) + 1] * bfhi(cur.hpv[e]) * bfhi(cur.cpv[e]));
                o[e] = cvtpk(lo, hi); }
            __builtin_nontemporal_store(o, (u32x4*)(MIX + (size_t)row * D + 768 + c8));
            cur = nxt;
        }
    }
}
constexpr int NCH = (CT + T) / 16, CH_REC = 12544, CH_AF = 0, CH_RF = 2048, CH_BKF = 4096, CH_MRF = 8192, CH_TF = 9216, CH_MAF = 9728, CH_GC = 10240, CH_VF = 10496;
constexpr int F3_ROWS = 0, F3_LM = 73728, F3_VROW = 106496, F3_GCL = 114688, F3_XCH = 116736, F3_CWT = 117760, F3_PRM = 126976, F3_ACTS = 134144;
#define WLDS_FENCE() asm volatile("s_waitcnt lgkmcnt(0)" ::: "memory")
#define DPPF(v, ctrl, fill) __builtin_bit_cast(float, __builtin_amdgcn_update_dpp(__builtin_bit_cast(int, (float)(fill)), __builtin_bit_cast(int, (v)), (ctrl), 0xf, 0xf, false))
__device__ __forceinline__ void ph_prep3f(const Frame& F0, int l) {
    const Frame F = fresh(F0);
    const bf16_t* REST = (const bf16_t*)(F.ws + WS_REST);
    bf16_t* RW = (bf16_t*)(F.ws + WS_R2);
    LAS float* CWT = (LAS float*)(F.lds + F3_CWT);
    LAS float* PRM = (LAS float*)(F.lds + F3_PRM);
    LAS bf16_t* ACTS = (LAS bf16_t*)(F.lds + F3_ACTS);
    LAS bf16_t* VROW = (LAS bf16_t*)(F.lds + F3_VROW);
    LAS float* GCL = (LAS float*)(F.lds + F3_GCL);
    LAS f32x2* XCH = (LAS f32x2*)(F.lds + F3_XCH);
    __syncthreads();
    {   const int ti = F.tid; f32x4 cwa, cwb = (f32x4){0.f, 0.f, 0.f, 0.f}, pr = cwb;
        cwa = *(const f32x4*)(F.in[I_RKVCONV] + (size_t)l * 3 * 768 + 4 * ti);
        if (ti < 64) cwb = *(const f32x4*)(F.in[I_RKVCONV] + (size_t)l * 3 * 768 + 2048 + 4 * ti);
        if (ti < 448) { const float* src = ti < 128 ? F.in[I_DW0] + l * 512 + 4 * ti : (ti < 256 ? F.in[I_A0] + l * 512 + 4 * (ti - 128) : (ti < 320 ? F.in[I_KK] + l * 256 + 4 * (ti - 256) : (ti < 384 ? F.in[I_KA] + l * 256 + 4 * (ti - 320) : F.in[I_RK] + l * 256 + 4 * (ti - 384))));
            pr = *(const f32x4*)src; }
        *(LAS f32x4*)(CWT + 4 * ti) = cwa; if (ti < 64) *(LAS f32x4*)(CWT + 2048 + 4 * ti) = cwb; if (ti < 448) *(LAS f32x4*)(PRM + 4 * ti) = pr;
    }
    const int h = F.wave >> 1, p = F.wave & 1;
    LAS bf16_t* rowsd = (LAS bf16_t*)(F.lds + F3_ROWS);
    LAS float* LM = (LAS float*)(F.lds + F3_LM + F.wave * 4096);
    LAS float* LT = LM;
    for (int u = F.bid; u < M / 16; u += F.G) {
        const int row0 = u * 16; const bool lat = row0 < BT; const int tseq = lat ? T : CT, t0 = lat ? (row0 % T) : ((row0 - BT) % CT);
        const int b = lat ? row0 / T : (row0 - BT) / CT, pc = lat ? CT / 16 + t0 / 16 : t0 / 16;
        int tl1 = F.tid; asm volatile("" : "+v"(tl1));
        const int lane = tl1 & 63, n = lane & 15, g = lane >> 4;
        const int row = row0 + n, t = t0 + n; const bool hm_ = t > 0, hp_ = t + 1 < tseq;
        if (tl1 < 384) { const int tk = tl1 / 24, gi = tl1 % 24;
            const u32x4 x = __builtin_nontemporal_load((const u32x4*)(REST + (size_t)(row0 + tk) * LDR + OWD + gi * 8)); u32x4 o;
#pragma unroll
            for (int e = 0; e < 4; ++e) { float lo = bflo(x[e]), hi = bfhi(x[e]);
                if (gi < 8) { lo = fast_tanh(lo); hi = fast_tanh(hi); } else if (gi >= 16) { lo = sigmoidf_(lo); hi = sigmoidf_(hi); }
                o[e] = cvtpk(lo, hi); }
            *(LAS u32x4*)(ACTS + tk * 200 + gi * 8) = o; }
        bf16x8 af[2][6];
#pragma unroll
        for (int c2 = 0; c2 < 2; ++c2)
#pragma unroll
            for (int w = 0; w < 6; ++w) af[c2][w] = *(const bf16x8*)(F.ws + WS_LW + ((size_t)((w * 16 + h * 4 + 2 * p + c2) * 64 + lane)) * 16);
        struct R9 { u32x2 r0, r1, r2, k0, k1, k2, v0, v1, v2; } r9[2];
        const unsigned mkm = hm_ ? 0xffffffffu : 0u, mkp = hp_ ? 0xffffffffu : 0u;
#pragma unroll
        for (int c2 = 0; c2 < 2; ++c2) { const bf16_t* pcn = REST + (size_t)row * LDR + h * 64 + (2 * p + c2) * 16 + 4 * g;
            const bf16_t* pm = hm_ ? pcn - LDR : pcn; const bf16_t* pp = hp_ ? pcn + LDR : pcn;
            r9[c2].r1 = *(const u32x2*)(pcn + ORR); r9[c2].k1 = *(const u32x2*)(pcn + ORK); r9[c2].v1 = *(const u32x2*)(pcn + ORV);
            r9[c2].r0 = *(const u32x2*)(pm + ORR); r9[c2].k0 = *(const u32x2*)(pm + ORK); r9[c2].v0 = *(const u32x2*)(pm + ORV);
            r9[c2].r2 = *(const u32x2*)(pp + ORR); r9[c2].k2 = *(const u32x2*)(pp + ORK); r9[c2].v2 = *(const u32x2*)(pp + ORV); }
        __syncthreads();
        float ss = 0.f, bon = 0.f;
        {
            bf16x8 bf[6];
#pragma unroll
            for (int w = 0; w < 6; ++w) bf[w] = *(const LAS bf16x8*)(ACTS + n * 200 + w * 32 + 8 * g);
            const f32x4 z4 = (f32x4){0.f, 0.f, 0.f, 0.f};
#define CONV4(dst, a0_, a1_, a2_, off) { const f32x4 w0_ = *(const LAS f32x4*)(CWT + 0 * 768 + (off) + c0), w1_ = *(const LAS f32x4*)(CWT + 1 * 768 + (off) + c0), w2_ = *(const LAS f32x4*)(CWT + 2 * 768 + (off) + c0); \
                dst = (f32x4){w0_[0] * bflo(a0_.x) + w1_[0] * bflo(a1_.x) + w2_[0] * bflo(a2_.x), w0_[1] * bfhi(a0_.x) + w1_[1] * bfhi(a1_.x) + w2_[1] * bfhi(a2_.x), \
                              w0_[2] * bflo(a0_.y) + w1_[2] * bflo(a1_.y) + w2_[2] * bflo(a2_.y), w0_[3] * bfhi(a0_.y) + w1_[3] * bfhi(a1_.y) + w2_[3] * bfhi(a2_.y)}; }
#define PK4(x_) (u32x2){cvtpk((x_)[0], (x_)[1]), cvtpk((x_)[2], (x_)[3])}
#pragma unroll
            for (int c2 = 0; c2 < 2; ++c2) { const int ct = 2 * p + c2, c0 = h * 64 + ct * 16 + 4 * g, cl = ct * 16 + 4 * g;
                const f32x4 aW0c = __builtin_amdgcn_mfma_f32_16x16x32_bf16(af[c2][0], bf[0], z4, 0, 0, 0), aW1c = __builtin_amdgcn_mfma_f32_16x16x32_bf16(af[c2][1], bf[1], z4, 0, 0, 0);
                const f32x4 aA0c = __builtin_amdgcn_mfma_f32_16x16x32_bf16(af[c2][2], bf[2], z4, 0, 0, 0), aA1c = __builtin_amdgcn_mfma_f32_16x16x32_bf16(af[c2][3], bf[3], z4, 0, 0, 0);
                f32x4 aGc = __builtin_amdgcn_mfma_f32_16x16x32_bf16(af[c2][4], bf[4], z4, 0, 0, 0); aGc = __builtin_amdgcn_mfma_f32_16x16x32_bf16(af[c2][5], bf[5], aGc, 0, 0, 0);
                R9& q = r9[c2];
                q.r0.x &= mkm; q.r0.y &= mkm; q.k0.x &= mkm; q.k0.y &= mkm; q.v0.x &= mkm; q.v0.y &= mkm; q.r2.x &= mkp; q.r2.y &= mkp; q.k2.x &= mkp; q.k2.y &= mkp; q.v2.x &= mkp; q.v2.y &= mkp;
                f32x4 rc, kc, vc;
                CONV4(rc, q.r0, q.r1, q.r2, 0) CONV4(kc, q.k0, q.k1, q.k2, 256) CONV4(vc, q.v0, q.v1, q.v2, 512)
                const f32x4 w00 = *(const LAS f32x4*)(PRM + c0), w01 = *(const LAS f32x4*)(PRM + 256 + c0), a00 = *(const LAS f32x4*)(PRM + 512 + c0), a01 = *(const LAS f32x4*)(PRM + 768 + c0);
                const f32x4 kkw = *(const LAS f32x4*)(PRM + 1024 + c0), kaw = *(const LAS f32x4*)(PRM + 1280 + c0), rkw = *(const LAS f32x4*)(PRM + 1536 + c0);
                f32x4 dec0, dec1, ia0, ia1;
#pragma unroll
                for (int e = 0; e < 4; ++e) { dec0[e] = __expf(-0.6065306597126334f * sigmoidf_(w00[e] + aW0c[e])); dec1[e] = __expf(-0.6065306597126334f * sigmoidf_(w01[e] + aW1c[e]));
                    ia0[e] = sigmoidf_(a00[e] + aA0c[e]); ia1[e] = sigmoidf_(a01[e] + aA1c[e]); }
                const f32x4 kd0 = kc * (1.0f + (ia0 - 1.0f) * kaw), kd1 = kc * (1.0f + (ia1 - 1.0f) * kaw), kr = kc * kkw;
                { const f32x4 bq = rc * (kd0 + kd1) * rkw; bon += (bq[0] + bq[1]) + (bq[2] + bq[3]); }
                ss += (kr[0] * kr[0] + kr[1] * kr[1]) + (kr[2] * kr[2] + kr[3] * kr[3]);
                const size_t o = (size_t)row * 256 + c0; const u32x2 vpk = (u32x2){cvtpk(vc[0], vc[1]), cvtpk(vc[2], vc[3])};
                *(u32x2*)(RW + (size_t)RW_V * (RWSZ / 2) + o) = vpk; *(u32x2*)(RW + (size_t)RW_G * (RWSZ / 2) + o) = (u32x2){cvtpk(aGc[0], aGc[1]), cvtpk(aGc[2], aGc[3])};
                *(LAS u32x2*)(VROW + (h * 16 + n) * 64 + cl) = vpk;
                float A0[4], R0[4], B0[4], K0[4], A1[4], R1[4], B1[4], K1[4];
#pragma unroll
                for (int e = 0; e < 4; ++e) {
                    float gs = dec0[e];
                    gs *= DPPF(gs, 0x111, 1.0f); gs *= DPPF(gs, 0x112, 1.0f); gs *= DPPF(gs, 0x114, 1.0f); gs *= DPPF(gs, 0x118, 1.0f);
                    { const float gm1 = DPPF(gs, 0x111, 1.0f), ig = __builtin_amdgcn_rcpf(gs);
                      A0[e] = -kr[e] * gm1; R0[e] = rc[e] * gs; B0[e] = kr[e] * ia0[e] * ig; K0[e] = kd0[e] * ig;
                      if (n == 15) GCL[(h * 2 + 0) * 64 + cl + e] = gs; }
                    float gr = dec1[e];
                    gr *= DPPF(gr, 0x101, 1.0f); gr *= DPPF(gr, 0x102, 1.0f); gr *= DPPF(gr, 0x104, 1.0f); gr *= DPPF(gr, 0x108, 1.0f);
                    { const float gm1 = DPPF(gr, 0x101, 1.0f), ig = __builtin_amdgcn_rcpf(gr);
                      A1[e] = -kr[e] * gm1; R1[e] = rc[e] * gr; B1[e] = kr[e] * ia1[e] * ig; K1[e] = kd1[e] * ig;
                      if (n == 0) GCL[(h * 2 + 1) * 64 + cl + e] = gr; } }
                LAS bf16_t* r0p = rowsd + ((h * 2 + 0) * 4) * 1152 + n * 72 + cl; LAS bf16_t* r1p = rowsd + ((h * 2 + 1) * 4) * 1152 + (15 - n) * 72 + cl;
                *(LAS u32x2*)(r0p) = PK4(A0); *(LAS u32x2*)(r0p + 1152) = PK4(R0); *(LAS u32x2*)(r0p + 2304) = PK4(B0); *(LAS u32x2*)(r0p + 3456) = PK4(K0);
                *(LAS u32x2*)(r1p) = PK4(A1); *(LAS u32x2*)(r1p + 1152) = PK4(R1); *(LAS u32x2*)(r1p + 2304) = PK4(B1); *(LAS u32x2*)(r1p + 3456) = PK4(K1); }
#undef CONV4
#undef PK4
        }
        ss += __shfl_xor(ss, 16); ss += __shfl_xor(ss, 32); bon += __shfl_xor(bon, 16); bon += __shfl_xor(bon, 32);
        if (g == 0) XCH[(h * 2 + p) * 16 + n] = (f32x2){ss, bon};
        __syncthreads();
        {
            int tl3 = F.tid; asm volatile("" : "+v"(tl3));
            const int lane = tl3 & 63, t_ = lane & 15, g_ = lane >> 4;
            const int dir = p, chain = dir * 32 + b * 4 + h;
            const int cc = pc < CT / 16 ? (dir ? CT / 16 - 1 - pc : pc) : CT / 16 + (dir ? T / 16 - 1 - (pc - CT / 16) : pc - CT / 16);
            unsigned char* rec = F.ws + ch_off_c(chain) + (size_t)cc * CH_REC;
            LAS bf16_t* LAh = rowsd + ((h * 2 + dir) * 4) * 1152; LAS bf16_t* LRh = LAh + 1152; LAS bf16_t* LBh = LRh + 1152; LAS bf16_t* LKh = LBh + 1152;
            const LAS float* gcl = GCL + (h * 2 + dir) * 64;
            ((float*)(rec + CH_GC))[lane] = gcl[lane];
            {
                const int pos = dir ? 15 - t_ : t_; const f32x2 xa = XCH[(h * 2 + 0) * 16 + pos], xb = XCH[(h * 2 + 1) * 16 + pos];
                const float inorm = __builtin_amdgcn_rsqf(fmaxf(xa.x + xb.x, 1e-24f));
                if (dir == 0 && g_ == 0) ((float*)(F.ws + WS_BONUS))[(size_t)(row0 + t_) * 4 + h] = xa.y + xb.y;
#pragma unroll
                for (int q = 0; q < 2; ++q) { LAS u32x4* pa = (LAS u32x4*)(LAh + t_ * 72 + 16 * g_ + 8 * q); LAS u32x4* pb = (LAS u32x4*)(LBh + t_ * 72 + 16 * g_ + 8 * q); const u32x4 va = *pa, vb = *pb; u32x4 oa, ob;
#pragma unroll
                    for (int e = 0; e < 4; ++e) { oa[e] = cvtpk(bflo(va[e]) * inorm, bfhi(va[e]) * inorm); ob[e] = cvtpk(bflo(vb[e]) * inorm, bfhi(vb[e]) * inorm); }
                    *pa = oa; *pb = ob; }
                WLDS_FENCE();
            }
#pragma unroll
            for (int s2 = 0; s2 < 2; ++s2) {
                const u32x2 a0 = *(const LAS u32x2*)(LAh + t_ * 72 + 32 * s2 + 4 * g_), a1 = *(const LAS u32x2*)(LAh + t_ * 72 + 32 * s2 + 16 + 4 * g_);
                *(u32x4*)(rec + CH_AF + s2 * 1024 + lane * 16) = (u32x4){a0.x, a0.y, a1.x, a1.y};
                const u32x2 q0 = *(const LAS u32x2*)(LRh + t_ * 72 + 32 * s2 + 4 * g_), q1 = *(const LAS u32x2*)(LRh + t_ * 72 + 32 * s2 + 16 + 4 * g_);
                *(u32x4*)(rec + CH_RF + s2 * 1024 + lane * 16) = (u32x4){q0.x, q0.y, q1.x, q1.y}; }
            f32x4 mab = (f32x4){0.f, 0.f, 0.f, 0.f}, mak = mab, mrb = mab, mrk = mab;
#pragma unroll
            for (int s2 = 0; s2 < 2; ++s2) {
                const bf16x8 fa = *(const LAS bf16x8*)(LAh + t_ * 72 + 32 * s2 + 8 * g_), fr = *(const LAS bf16x8*)(LRh + t_ * 72 + 32 * s2 + 8 * g_);
                const bf16x8 fb = *(const LAS bf16x8*)(LBh + t_ * 72 + 32 * s2 + 8 * g_), fk = *(const LAS bf16x8*)(LKh + t_ * 72 + 32 * s2 + 8 * g_);
                mab = __builtin_amdgcn_mfma_f32_16x16x32_bf16(fa, fb, mab, 0, 0, 0); mak = __builtin_amdgcn_mfma_f32_16x16x32_bf16(fa, fk, mak, 0, 0, 0);
                mrb = __builtin_amdgcn_mfma_f32_16x16x32_bf16(fr, fb, mrb, 0, 0, 0); mrk = __builtin_amdgcn_mfma_f32_16x16x32_bf16(fr, fk, mrk, 0, 0, 0); }
            WLDS_FENCE();
#pragma unroll
            for (int r = 0; r < 4; ++r) { const int tt = 4 * g_ + r, i = t_;
                LM[0 * 256 + tt * 16 + i] = i < tt ? mab[r] : 0.f; LM[1 * 256 + tt * 16 + i] = i < tt ? mak[r] : 0.f;
                LM[2 * 256 + tt * 16 + i] = i <= tt ? mrb[r] : 0.f; LM[3 * 256 + tt * 16 + i] = i <= tt ? mrk[r] : 0.f; }
            WLDS_FENCE();
            { float Tc[16];
#pragma unroll
              for (int tt = 0; tt < 16; ++tt) { float acc = (tt == t_) ? 1.0f : 0.f;
#pragma unroll
                  for (int i = 0; i < tt; ++i) acc += LM[tt * 16 + i] * Tc[i];
                  Tc[tt] = acc; }
              WLDS_FENCE();
              if (g_ == 0) {
#pragma unroll
                  for (int tt = 0; tt < 16; ++tt) LT[tt * 16 + t_] = Tc[tt]; } }
            WLDS_FENCE();
            const f32x4 zz = (f32x4){0.f, 0.f, 0.f, 0.f};
            const u32x2 ttf = (u32x2){cvtpk(LT[(4 * g_ + 0) * 16 + t_], LT[(4 * g_ + 1) * 16 + t_]), cvtpk(LT[(4 * g_ + 2) * 16 + t_], LT[(4 * g_ + 3) * 16 + t_])};
            { const f32x4 ak4 = *(const LAS f32x4*)(LM + 256 + t_ * 16 + 4 * g_), rb4 = *(const LAS f32x4*)(LM + 512 + t_ * 16 + 4 * g_), rk4 = *(const LAS f32x4*)(LM + 768 + t_ * 16 + 4 * g_);
              const f32x4 rbt = __builtin_amdgcn_mfma_f32_16x16x16bf16_1k(BF4(ttf), BF4(((u32x2){cvtpk(rb4[0], rb4[1]), cvtpk(rb4[2], rb4[3])})), zz, 0, 0, 0);
              *(u32x2*)(rec + CH_MAF + lane * 8) = (u32x2){cvtpk(ak4[0], ak4[1]), cvtpk(ak4[2], ak4[3])};
              *(u32x4*)(rec + CH_MRF + lane * 16) = (u32x4){cvtpk(rbt[0], rbt[1]), cvtpk(rbt[2], rbt[3]), cvtpk(rk4[0], rk4[1]), cvtpk(rk4[2], rk4[3])}; }
#pragma unroll
            for (int kt = 0; kt < 4; ++kt) { const LAS bf16_t* pb = LBh + (4 * g_) * 72 + 16 * kt + t_; const LAS bf16_t* pk = LKh + (4 * g_) * 72 + 16 * kt + t_; const float gck = gcl[16 * kt + t_];
                const u32x2 bcol = (u32x2){(unsigned)pb[0] | ((unsigned)pb[72] << 16), (unsigned)pb[144] | ((unsigned)pb[216] << 16)};
                const f32x4 bt = __builtin_amdgcn_mfma_f32_16x16x16bf16_1k(BF4(ttf), BF4(bcol), zz, 0, 0, 0);
                u32x4 w; w.x = cvtpk(bt[0] * gck, bt[1] * gck); w.y = cvtpk(bt[2] * gck, bt[3] * gck); w.z = cvtpk(bf2f(pk[0]) * gck, bf2f(pk[72]) * gck); w.w = cvtpk(bf2f(pk[144]) * gck, bf2f(pk[216]) * gck);
                *(u32x4*)(rec + CH_BKF + kt * 1024 + lane * 16) = w; }
#pragma unroll
            for (int vq = 0; vq < 4; ++vq) { unsigned short v4[4];
#pragma unroll
                for (int i = 0; i < 4; ++i) { const int tt = 4 * g_ + i; v4[i] = VROW[(h * 16 + (dir ? 15 - tt : tt)) * 64 + vq * 16 + t_]; }
                *(u32x2*)(rec + CH_VF + vq * 512 + lane * 8) = (u32x2){(unsigned)v4[0] | ((unsigned)v4[1] << 16), (unsigned)v4[2] | ((unsigned)v4[3] << 16)}; }
        }
    }
}
#undef DPPF
__device__ __forceinline__ void ph_prep(const Frame& F, int l, bool writeq = true) {
#ifndef DIS_P1
    if ((REP_MASK >> 13) & 1) ph_prep1(F, l, false);
    ph_prep1(F, l, writeq);
#endif
#ifndef DIS_P2
    if ((REP_MASK >> 14) & 1) ph_prep2(F, l);
    ph_prep2(F, l);
#endif
}

__device__ __forceinline__ int chain_rowbase(int dir, int b, int cc) { if (cc < CT / 16) { const int pc = dir ? CT / 16 - 1 - cc : cc; return BT + b * CT + pc * 16; } const int pc = dir ? T / 16 - 1 - (cc - CT / 16) : cc - CT / 16; return b * T + pc * 16; }
struct ScanOps { u32x4 af0, af1, rf0, rf1, bk0, bk1, bk2, bk3, mrf; u32x2 maf, vf; f32x4 gc0, gc1, gc2, gc3; };
__device__ __forceinline__ void scan_load(ScanOps& o, const LAS unsigned char* rec, int lane, int g_, int vq) {
    o.af0 = *(const LAS u32x4*)(rec + CH_AF + lane * 16); o.af1 = *(const LAS u32x4*)(rec + CH_AF + 1024 + lane * 16);
    o.rf0 = *(const LAS u32x4*)(rec + CH_RF + lane * 16); o.rf1 = *(const LAS u32x4*)(rec + CH_RF + 1024 + lane * 16);
    o.bk0 = *(const LAS u32x4*)(rec + CH_BKF + lane * 16); o.bk1 = *(const LAS u32x4*)(rec + CH_BKF + 1024 + lane * 16); o.bk2 = *(const LAS u32x4*)(rec + CH_BKF + 2048 + lane * 16); o.bk3 = *(const LAS u32x4*)(rec + CH_BKF + 3072 + lane * 16);
    o.mrf = *(const LAS u32x4*)(rec + CH_MRF + lane * 16); o.maf = *(const LAS u32x2*)(rec + CH_MAF + lane * 8); o.vf = *(const LAS u32x2*)(rec + CH_VF + vq * 512 + lane * 8);
    const LAS float* gc = (const LAS float*)(rec + CH_GC) + 4 * g_;
    o.gc0 = *(const LAS f32x4*)(gc); o.gc1 = *(const LAS f32x4*)(gc + 16); o.gc2 = *(const LAS f32x4*)(gc + 32); o.gc3 = *(const LAS f32x4*)(gc + 48);
}
#define BF8(v) __builtin_bit_cast(bf16x8, (v))
constexpr int SCAN_NS = 10;
#define SCAN_BAR() do { asm volatile("s_waitcnt lgkmcnt(0)" ::: "memory"); __builtin_amdgcn_s_barrier(); asm volatile("" ::: "memory"); } while (0)
template <int NI> __device__ __forceinline__ void scan_issue(LAS unsigned char* lds, const unsigned char* recs, int c, int wl, int lane) {
    const unsigned char* src = recs + (size_t)c * CH_REC; LAS unsigned char* dst = lds + (c % SCAN_NS) * CH_REC;
#pragma unroll
    for (int i = 0; i < 3; ++i) { const int chunk = i * 4 + wl; __builtin_amdgcn_global_load_lds((const unsigned*)(src + chunk * 1024 + lane * 16), (LAS unsigned*)(dst + chunk * 1024), 16, 0, 0); }
    if (NI == 4) { if (lane < 16) __builtin_amdgcn_global_load_lds((const unsigned*)(src + 12 * 1024 + lane * 16), (LAS unsigned*)(dst + 12 * 1024), 16, 0, 0); }
}
template <int NI> __device__ __forceinline__ void scan_loader(LAS unsigned char* lds, const unsigned char* recs, int wl, int lane) {
#pragma unroll
    for (int c = 0; c < SCAN_NS - 1; ++c) scan_issue<NI>(lds, recs, c, wl, lane);
    if (NI == 4) asm volatile("s_waitcnt vmcnt(32)" ::: "memory"); else asm volatile("s_waitcnt vmcnt(24)" ::: "memory");
    SCAN_BAR();
    for (int cc = 0; cc < NCH; ++cc) {
        if (cc + SCAN_NS - 2 < NCH) { if (NI == 4) asm volatile("s_waitcnt vmcnt(28)" ::: "memory"); else asm volatile("s_waitcnt vmcnt(21)" ::: "memory"); }
        else asm volatile("s_waitcnt vmcnt(0)" ::: "memory");
        SCAN_BAR();
        if (cc + SCAN_NS - 1 < NCH) scan_issue<NI>(lds, recs, cc + SCAN_NS - 1, wl, lane);
    }
}
__device__ __forceinline__ void ph_seqscan(const Frame& F0, int l) {
    const Frame F = fresh(F0);
    if (F.bid >= 64) return;
    const int chain = F.bid, lane = F.lane;
    const unsigned char* recs = F.ws + ch_off_c(chain);
    if (F.wave >= 4) { if (F.wave == 4) scan_loader<4>(F.lds, recs, 0, lane); else scan_loader<3>(F.lds, recs, F.wave - 4, lane); return; }
    const int vq = F.wave, v_ = lane & 15, g_ = lane >> 4, dir = chain >> 5, b = (chain >> 2) & 7, h = chain & 3;
    unsigned* YD2 = (unsigned*)(F.ws + WS_YD) + (size_t)dir * (M / 2) * 256 + h * 64 + vq * 16 + v_;
    unsigned* prog = F.ctl + CW_PROG + (l * 64 + chain) * 16;
    float zf = 0.f; asm volatile("" : "+v"(zf));
    const f32x4 z4 = (f32x4){zf, zf, zf, zf};
    f32x4 st0 = z4, st1 = z4, st2 = z4, st3 = z4;
#define SCAN_STEP(cur, cc) do { \
        const u32x4 sb0 = (u32x4){cvtpk(st0[0], st0[1]), cvtpk(st0[2], st0[3]), cvtpk(st1[0], st1[1]), cvtpk(st1[2], st1[3])}; \
        const u32x4 sb1 = (u32x4){cvtpk(st2[0], st2[1]), cvtpk(st2[2], st2[3]), cvtpk(st3[0], st3[1]), cvtpk(st3[2], st3[3])}; \
        f32x4 x = __builtin_amdgcn_mfma_f32_16x16x16bf16_1k(BF4(cur.maf), BF4(cur.vf), z4, 0, 0, 0);     \
        x = __builtin_amdgcn_mfma_f32_16x16x32_bf16(BF8(cur.af0), BF8(sb0), x, 0, 0, 0); \
        x = __builtin_amdgcn_mfma_f32_16x16x32_bf16(BF8(cur.af1), BF8(sb1), x, 0, 0, 0); \
        const u32x4 uv = (u32x4){cvtpk(x[0], x[1]), cvtpk(x[2], x[3]), cur.vf.x, cur.vf.y};     \
        f32x4 y = __builtin_amdgcn_mfma_f32_16x16x32_bf16(BF8(cur.rf0), BF8(sb0), z4, 0, 0, 0); \
        y = __builtin_amdgcn_mfma_f32_16x16x32_bf16(BF8(cur.rf1), BF8(sb1), y, 0, 0, 0); \
        y = __builtin_amdgcn_mfma_f32_16x16x32_bf16(BF8(cur.mrf), BF8(uv), y, 0, 0, 0); \
        st0 = __builtin_amdgcn_mfma_f32_16x16x32_bf16(BF8(cur.bk0), BF8(uv), st0 * cur.gc0, 0, 0, 0); \
        st1 = __builtin_amdgcn_mfma_f32_16x16x32_bf16(BF8(cur.bk1), BF8(uv), st1 * cur.gc1, 0, 0, 0); \
        st2 = __builtin_amdgcn_mfma_f32_16x16x32_bf16(BF8(cur.bk2), BF8(uv), st2 * cur.gc2, 0, 0, 0); \
        st3 = __builtin_amdgcn_mfma_f32_16x16x32_bf16(BF8(cur.bk3), BF8(uv), st3 * cur.gc3, 0, 0, 0); \
          \
        if (dir) { yp[0] = cvtpk(y[1], y[0]); yp[-256] = cvtpk(y[3], y[2]); }        \
        else { yp[0] = cvtpk(y[0], y[1]); yp[256] = cvtpk(y[2], y[3]); } \
        yp += ystep; } while (0)
    ScanOps cur, nxt;
    SCAN_BAR();
    scan_load(cur, F.lds, lane, g_, vq);
    int slot = 0;
    const int ystep = dir ? -8 * 256 : 8 * 256;
#pragma unroll 1
    for (int seg = 0; seg < 2; ++seg) {
        const int nseg = seg ? T / 16 : CT / 16, rb0 = chain_rowbase(dir, b, seg ? CT / 16 : 0);
        unsigned* yp = YD2 + (size_t)((rb0 >> 1) + (dir ? 7 - 2 * g_ : 2 * g_)) * 256;
#pragma unroll 1
        for (int k = 0; k < nseg; k += 2) {
            if (vq == 0 && (k & 7) == 0 && lane == 0) __hip_atomic_store(prog, (unsigned)((seg ? CT / 16 : 0) + k), __ATOMIC_RELAXED, __HIP_MEMORY_SCOPE_AGENT);
            SCAN_BAR();
            slot = slot + 1 == SCAN_NS ? 0 : slot + 1;
            scan_load(nxt, F.lds + slot * CH_REC, lane, g_, vq);
            SCAN_STEP(cur, 0);
            SCAN_BAR();
            if (seg == 0 || k + 2 < nseg) slot = slot + 1 == SCAN_NS ? 0 : slot + 1;
            scan_load(cur, F.lds + slot * CH_REC, lane, g_, vq);
            SCAN_STEP(nxt, 0);
        }
    }
#undef SCAN_STEP
}
static_assert(NCH % 2 == 0, "the scan's chunk loop is unrolled by two");

__device__ __forceinline__ void ph_scan_warm(const Frame& F0, int l) {
    const Frame F = fresh(F0);
    const int vb = F.bid - 64, j = vb >> 3; if (vb < 0 || j >= 24) return;
    const int chain = ((j & 7) << 3) | (F.bid & 7), sub = j >> 3;
    unsigned* prog = F.ctl + CW_PROG + (l * 64 + chain) * 16;
    const unsigned char* recs = F.ws + ch_off_c(chain);
    constexpr int LEAD = 24;
    unsigned acc = 0u;
    for (int q = sub; q * 8 < NCH; q += 3) {
        const int need = q * 8 - LEAD;
        int p = (int)__builtin_amdgcn_readfirstlane((int)__hip_atomic_load(prog, __ATOMIC_RELAXED, __HIP_MEMORY_SCOPE_AGENT));
        for (unsigned spins = 0; p < need; ++spins) { if (spins > 200000u) return; __builtin_amdgcn_s_sleep(8); p = (int)__builtin_amdgcn_readfirstlane((int)__hip_atomic_load(prog, __ATOMIC_RELAXED, __HIP_MEMORY_SCOPE_AGENT)); }
        if (p > q * 8 + 8) continue;
        const unsigned char* r = recs + (size_t)(q * 8 + F.wave) * CH_REC;
        if (F.lane < 49) { acc ^= *(const volatile unsigned*)(r + F.lane * 256); acc ^= *(const volatile unsigned*)(r + F.lane * 256 + 128); }
    }
    if (acc == 0x5a17c0deu && F.lane == 77) prog[1] = acc;
}

typedef float f32x16 __attribute__((ext_vector_type(16)));
#define ATT_WAITV(n) asm volatile("s_waitcnt vmcnt(" #n ")" ::: "memory")
#define ATT_BAR() do { asm volatile("s_waitcnt lgkmcnt(0)" ::: "memory"); __builtin_amdgcn_s_barrier(); asm volatile("" ::: "memory"); } while (0)
constexpr int ATT_KRING = 0, ATT_VRING = 49152, ATT_XCH = 98304;
__device__ __forceinline__ void att_issue_k(LAS unsigned char* lds, const unsigned char* img, int tile, int wave, int lane) {
#pragma unroll
    for (int i = 0; i < 2; ++i) { const int chunk = i * 8 + wave;
        __builtin_amdgcn_global_load_lds((const unsigned*)(img + (size_t)tile * ATT_TILEB + chunk * 1024 + lane * 16), (LAS unsigned*)(lds + ATT_KRING + (tile % 3) * 16384 + chunk * 1024), 16, 0, 0); }
}
__device__ __forceinline__ void att_issue_v(LAS unsigned char* lds, const unsigned char* img, int tile, int wave, int lane) {
#pragma unroll
    for (int i = 0; i < 2; ++i) { const int chunk = i * 8 + wave;
        __builtin_amdgcn_global_load_lds((const unsigned*)(img + (size_t)tile * ATT_TILEB + 16384 + chunk * 1024 + lane * 16), (LAS unsigned*)(lds + ATT_VRING + (tile % 3) * 16384 + chunk * 1024), 16, 0, 0); }
}
__device__ __forceinline__ void attn_unit(const Frame& F, int l, int b, int h, int row0, int nt, float lam, float post) {
    LAS unsigned char* lds = F.lds;
    const int wave = F.wave, lane = F.lane, qg = wave >> 1, map = wave & 1, ql = lane & 31, hi = lane >> 5;
    const unsigned char* img = F.ws + WS_KV + (size_t)(b * 4 + h) * NT_LAT * ATT_TILEB;
    const int row = row0 + qg * 32 + ql;
    const bf16_t* Q = (const bf16_t*)(F.ws + WS_QKV) + (size_t)row * LDQ + OQ + h * 128 + map * 64 + hi * 8;
    bf16x8 qf[4];
#pragma unroll
    for (int ks = 0; ks < 4; ++ks) qf[ks] = *(const bf16x8*)(Q + 16 * ks);
    att_issue_k(lds, img, 0, wave, lane); att_issue_k(lds, img, 1, wave, lane); att_issue_v(lds, img, 0, wave, lane);
    f32x16 o[4];
#pragma unroll
    for (int dt = 0; dt < 4; ++dt)
#pragma unroll
        for (int r = 0; r < 16; ++r) o[dt][r] = 0.f;
    float mref = -1.0e30f, lsum = 0.f, pend = 1.0f;
    const int koff = ATT_KRING + map * 8192 + (hi * 64 + ql) * 16, voff = ATT_VRING + (hi * 32 + ql) * 16;
    u32x4 pfp[4], pfn[4];
#pragma unroll
    for (int j = 0; j < 4; ++j) pfp[j] = (u32x4){0u, 0u, 0u, 0u};
    for (int t = 0; t < nt; ++t) {
        if (t + 1 < nt) ATT_WAITV(4); else ATT_WAITV(2);
        ATT_BAR();
        if (t + 2 < nt) att_issue_k(lds, img, t + 2, wave, lane);
        if (t + 1 < nt) att_issue_v(lds, img, t + 1, wave, lane);
        const float sbias = mref < -1.0e29f ? 0.f : mref;
        f32x16 s0, s1;
        {
            const LAS unsigned char* kp = lds + koff + (t % 3) * 16384;
            bf16x8 kf[8];
#pragma unroll
            for (int ks = 0; ks < 4; ++ks) { kf[2 * ks] = *(const LAS bf16x8*)(kp + ks * 2048); kf[2 * ks + 1] = *(const LAS bf16x8*)(kp + ks * 2048 + 512); }
#pragma unroll
            for (int r = 0; r < 16; ++r) { s0[r] = -sbias; s1[r] = -sbias; }
            __builtin_amdgcn_sched_barrier(0);
#pragma unroll
            for (int ks = 0; ks < 4; ++ks) { s0 = __builtin_amdgcn_mfma_f32_32x32x16_bf16(kf[2 * ks], qf[ks], s0, 0, 0, 0); s1 = __builtin_amdgcn_mfma_f32_32x32x16_bf16(kf[2 * ks + 1], qf[ks], s1, 0, 0, 0); }
        }
        const LAS unsigned char* vp = t > 0 ? lds + voff + ((t + 2) % 3) * 16384 : lds + ATT_KRING + (hi * 32 + ql) * 16;
        bf16x8 vfr[4];
#pragma unroll
        for (int i = 0; i < 3; ++i) vfr[i] = *(const LAS bf16x8*)(vp + (i * 2) * 512);
        float mx = fmaxf(fmaxf(s0[0], s1[0]), fmaxf(s0[1], s1[1]));
#pragma unroll
        for (int r = 2; r < 16; r += 2) mx = fmaxf(fmaxf(mx, s0[r]), fmaxf(s1[r], fmaxf(s0[r + 1], s1[r + 1])));
        { const auto rr = __builtin_amdgcn_permlane32_swap(__float_as_uint(mx), __float_as_uint(mx), false, false);
          mx = fmaxf(__uint_as_float(rr[0]), __uint_as_float(rr[1])) + sbias; }
        if (__any(pend != 1.0f || mx > mref + 8.0f)) {
#pragma unroll
            for (int dt = 0; dt < 4; ++dt)
#pragma unroll
                for (int r = 0; r < 16; ++r) o[dt][r] *= pend;
            const float mnew = (mx > mref + 8.0f) ? mx : mref, delta = sbias - mnew;
            pend = __builtin_amdgcn_exp2f(mref - mnew);
#pragma unroll
            for (int r = 0; r < 16; ++r) { s0[r] += delta; s1[r] += delta; }
            lsum *= pend; mref = mnew;
        }
        __builtin_amdgcn_sched_barrier(0);
        float ps = 0.f;
#pragma unroll
        for (int i = 0; i < 16; ++i) {
            if (i + 3 < 16) vfr[(i + 3) & 3] = *(const LAS bf16x8*)(vp + ((i + 3) * 2) * 512);
            o[i >> 2] = __builtin_amdgcn_mfma_f32_32x32x16_bf16(vfr[i & 3], __builtin_bit_cast(bf16x8, pfp[i & 3]), o[i >> 2], 0, 0, 0);
            s0[i] = __builtin_amdgcn_exp2f(s0[i]); s1[i] = __builtin_amdgcn_exp2f(s1[i]); ps += s0[i]; ps += s1[i];
            if (i & 1) { pfn[i >> 3][(i & 7) >> 1] = cvtpk(s0[i - 1], s0[i]); pfn[2 + (i >> 3)][(i & 7) >> 1] = cvtpk(s1[i - 1], s1[i]); }
            __builtin_amdgcn_sched_barrier(0);
        }
        lsum += ps;
#pragma unroll
        for (int j = 0; j < 4; ++j) pfp[j] = pfn[j];
    }
    ATT_WAITV(0); ATT_BAR();
    {
#pragma unroll
        for (int dt = 0; dt < 4; ++dt)
#pragma unroll
            for (int r = 0; r < 16; ++r) o[dt][r] *= pend;
        const LAS unsigned char* vp = lds + voff + ((nt - 1) % 3) * 16384;
#pragma unroll
        for (int hf = 0; hf < 2; ++hf) { bf16x8 vf[8];
#pragma unroll
            for (int i = 0; i < 8; ++i) vf[i] = *(const LAS bf16x8*)(vp + ((hf * 8 + i) * 2) * 512);
            __builtin_amdgcn_sched_barrier(0);
#pragma unroll
            for (int i = 0; i < 8; ++i) o[hf * 2 + (i >> 2)] = __builtin_amdgcn_mfma_f32_32x32x16_bf16(vf[i], __builtin_bit_cast(bf16x8, pfp[i & 3]), o[hf * 2 + (i >> 2)], 0, 0, 0); }
    }
    const float ltot = lsum + __shfl_xor(lsum, 32);
    LAS unsigned* xch = (LAS unsigned*)(lds + ATT_XCH + qg * 8192);
    if (map == 1) { const float sc = lam / ltot;
#pragma unroll
        for (int dt = 0; dt < 4; ++dt)
#pragma unroll
            for (int r = 0; r < 16; r += 2) xch[(dt * 8 + (r >> 1)) * 64 + lane] = cvtpk(o[dt][r] * sc, o[dt][r + 1] * sc); }
    ATT_BAR();
    if (map == 0) { const float inv = 1.0f / ltot; float ss = 0.f;
#pragma unroll
        for (int dt = 0; dt < 4; ++dt)
#pragma unroll
            for (int r = 0; r < 16; r += 2) { const unsigned w = xch[(dt * 8 + (r >> 1)) * 64 + lane]; o[dt][r] = o[dt][r] * inv - bflo(w); o[dt][r + 1] = o[dt][r + 1] * inv - bfhi(w); ss += o[dt][r] * o[dt][r] + o[dt][r + 1] * o[dt][r + 1]; }
        ss += __shfl_xor(ss, 32);
        const float sc = post / sqrtf(ss * (1.0f / 128.0f) + SUBLN_EPS);
        const float* sg = F.in[I_SUBLN] + l * 128;
        bf16_t* orow = (bf16_t*)(F.ws + WS_ACT) + (size_t)row * D + h * 128;
#pragma unroll
        for (int dt = 0; dt < 4; ++dt)
#pragma unroll
            for (int rq = 0; rq < 4; ++rq) { const int d = 32 * dt + 8 * rq + 4 * hi; const f32x4 g = *(const f32x4*)(sg + d);
                u32x2 w; w.x = cvtpk(o[dt][4 * rq] * sc * g[0], o[dt][4 * rq + 1] * sc * g[1]); w.y = cvtpk(o[dt][4 * rq + 2] * sc * g[2], o[dt][4 * rq + 3] * sc * g[3]);
                *(u32x2*)(orow + d) = w; }
    }
}
__device__ __forceinline__ void ph_attn(const Frame& F0, int l) {
    const Frame F = fresh(F0);
    const float lam = ((const float*)(F.ws + WS_LAM))[l];
    const float post = 1.0f - (0.8f - 0.6f * expf(-0.3f * (float)l));
    constexpr int NU_LAT = NB * 4 * (T / 128);
    for (int U = F.bid; U < NU_LAT; U += F.G) {
        const int x = U & 7, j = (U >> 3) & 31, i = U >> 8, pair = x + 8 * i;
        attn_unit(F, l, pair >> 2, pair & 3, (pair >> 2) * T + j * 128, NT_LAT, lam, post);
    }
    if (l < DEPTH - 1)
        for (int U = F.bid; U < NB * 4 * (CT / 128); U += F.G) { const int pair = U >> 1, qb = U & 1;
            attn_unit(F, l, pair >> 2, pair & 3, BT + (pair >> 2) * CT + qb * 128, NT_CTX, lam, post); }
}
__device__ __forceinline__ float row16_sum(float v) { v = DPP_ADD(v, 0xB1); v = DPP_ADD(v, 0x4E); v = DPP_ADD(v, 0x141); v = DPP_ADD(v, 0x140); return v; }
__device__ __forceinline__ void ph_rwkv_out(const Frame& F0, int l) {
    const Frame F = fresh(F0);
    constexpr int R = 4;
    const int nrows = l < DEPTH - 1 ? M : BT;
    const int c4 = 4 * F.lane, h = F.lane >> 4;
    const bf16_t* RW = (const bf16_t*)(F.ws + WS_R2); const unsigned* YD2 = (const unsigned*)(F.ws + WS_YD); bf16_t* MIX = (bf16_t*)(F.ws + WS_ACT);
    const f32x4 gg = *(const f32x4*)(F.in[I_GNG] + l * 256 + c4), gb = *(const f32x4*)(F.in[I_GNB] + l * 256 + c4);
    for (int grp = F.bid * NWAVES + F.wave; grp < nrows / R; grp += F.G * NWAVES) {
        u32x2 vv[R], gt[R]; float bon[R]; u32x4 ya[2], yb[2];
#pragma unroll
        for (int q = 0; q < 2; ++q) { const size_t o2 = (size_t)(grp * 2 + q) * 256 + c4; ya[q] = __builtin_nontemporal_load((const u32x4*)(YD2 + o2)); yb[q] = __builtin_nontemporal_load((const u32x4*)(YD2 + (size_t)(M / 2) * 256 + o2)); }
#pragma unroll
        for (int r = 0; r < R; ++r) { const size_t o = (size_t)(grp * R + r) * 256 + c4;
            vv[r] = __builtin_nontemporal_load((const u32x2*)(RW + RW_V * (RWSZ / 2) + o)); gt[r] = __builtin_nontemporal_load((const u32x2*)(RW + RW_G * (RWSZ / 2) + o));
            bon[r] = ((const float*)(F.ws + WS_BONUS))[(size_t)(grp * R + r) * 4 + h]; }
#pragma unroll
        for (int r = 0; r < R; ++r) {
            const u32x4 wa = ya[r >> 1], wb = yb[r >> 1];
            f32x4 y = (r & 1) ? (f32x4){bfhi(wa[0]) + bfhi(wb[0]), bfhi(wa[1]) + bfhi(wb[1]), bfhi(wa[2]) + bfhi(wb[2]), bfhi(wa[3]) + bfhi(wb[3])}
                              : (f32x4){bflo(wa[0]) + bflo(wb[0]), bflo(wa[1]) + bflo(wb[1]), bflo(wa[2]) + bflo(wb[2]), bflo(wa[3]) + bflo(wb[3])};
            const float mu = row16_sum((y[0] + y[1]) + (y[2] + y[3])) * (1.0f / 64.0f); y = y - mu;
            const float var = row16_sum((y[0] * y[0] + y[1] * y[1]) + (y[2] * y[2] + y[3] * y[3])) * (1.0f / 64.0f);
            const float rs = 1.0f / sqrtf(var + GN_EPS);
            const f32x4 v4 = (f32x4){bflo(vv[r].x), bfhi(vv[r].x), bflo(vv[r].y), bfhi(vv[r].y)}, g4 = (f32x4){bflo(gt[r].x), bfhi(gt[r].x), bflo(gt[r].y), bfhi(gt[r].y)};
            const f32x4 o4 = (y * rs * gg + gb + bon[r] * v4) * g4;
            *(u32x2*)(MIX + (size_t)(grp * R + r) * D + 512 + c4) = (u32x2){cvtpk(o4[0], o4[1]), cvtpk(o4[2], o4[3])};
        }
    }
}

constexpr int NSL = 12, NSTEP = 2 + NSL * DEPTH;
#ifndef GEMM_MASK
#define GEMM_MASK 63
#endif
#if (GEMM_MASK >> 0) & 1
#define GEMMCALL0(a, b, c, d) pg8::gemm_phase(a, b, c, d, F.wave)
#else
#define GEMMCALL0(a, b, c, d) do {} while (0)
#endif
#if (GEMM_MASK >> 1) & 1
#define GEMMCALL1(a, b, c, d) pg8::gemm_phase(a, b, c, d, F.wave)
#else
#define GEMMCALL1(a, b, c, d) do {} while (0)
#endif
#if (GEMM_MASK >> 2) & 1
#define GEMMCALL2(a, b, c, d) pg8::gemm_phase(a, b, c, d, F.wave)
#else
#define GEMMCALL2(a, b, c, d) do {} while (0)
#endif
#if (GEMM_MASK >> 3) & 1
#define GEMMCALL3(a, b, c, d) pg8::gemm_phase(a, b, c, d, F.wave)
#else
#define GEMMCALL3(a, b, c, d) do {} while (0)
#endif
#if (GEMM_MASK >> 4) & 1
#define GEMMCALL4(a, b, c, d) pg8::gemm_phase(a, b, c, d, F.wave)
#else
#define GEMMCALL4(a, b, c, d) do {} while (0)
#endif
#if (GEMM_MASK >> 5) & 1
#define GEMMCALL5(a, b, c, d) pg8::gemm_phase(a, b, c, d, F.wave)
#else
#define GEMMCALL5(a, b, c, d) do {} while (0)
#endif
__global__ void __launch_bounds__(NTHR, 2) fwd_kernel(Args args) {
    extern __shared__ __attribute__((aligned(16))) unsigned char lds_raw[];
    Frame F;
    F.lds = (LAS unsigned char*)lds_raw;
    F.tid = threadIdx.x; F.lane = F.tid & 63; F.wave = __builtin_amdgcn_readfirstlane(F.tid >> 6);
    F.G = gridDim.x; F.bid = blockIdx.x;
    F.in = args.in; F.out = args.out; F.ws = args.ws; F.ctl = (unsigned*)(args.ws + WS_CTL);
    volatile LAS unsigned* MISC = (volatile LAS unsigned*)(F.lds + MISC_OFF);
    for (int u = F.tid; u < (LDS_BYTES - RING_BYTES) / 4; u += NTHR) ((LAS unsigned*)(F.lds + RING_BYTES))[u] = 0u;
    __syncthreads();
    const int s_lo = args.s_lo, s_hi = args.s_hi;
    XcdBarrier bar; bar.bar = F.ctl + CW_BAR; bar.x = 0; bar.st = nullptr;
    if (s_hi - s_lo > 1) bar = xcd_barrier_post(F.ctl + CW_BAR, MISC + 8);
#define IN(s) (s_lo <= (s) && (s) < s_hi)
#ifndef PROBE_BAR2
#define PROBE_BAR2 0
#endif
#define SEAM(s) do { if ((s) + 1 < s_hi) { xcd_barrier(bar, F.wave); if (PROBE_BAR2) xcd_barrier(bar, F.wave); } } while (0)
#define REPS(k) (((REP_MASK >> (k)) & 1) ? 2 : 1)

#ifndef DIS_PRE
    if (IN(0)) { _Pragma("nounroll") for (int rp = 0; rp < REPS(0); ++rp) { ph_mods(F, 0, 1, F.bid, F.G); ph_convert(F, 0, 0, F.bid, F.G); } SEAM(0); }
#endif
#ifndef DIS_LN
    if (IN(1)) { _Pragma("nounroll") for (int rp = 0; rp < REPS(9); ++rp) { ph_ln<0>(F, 0, rp + 1 < REPS(9)); } SEAM(1); }
#endif
    for (int l = 0; l < DEPTH; ++l) {
        const int sb = 2 + NSL * l;
        const int mact = l < DEPTH - 1 ? M : BT;
        const float* gates = (const float*)(F.ws + WS_MODS) + (size_t)l * 9 * 6 * D;
        if (IN(sb + 0)) {
            pg8::Gemm g{(const bf16_t*)(F.ws + WS_ACT), (const bf16_t*)(F.ws + WS_WIN), D, 0}; pg8::StaticOrder S; S.init(M, NPROJP, F.G, F.bid);
            pg8::EpiBf16 E{(bf16_t*)(F.ws + WS_QKV), LDQ, (bf16_t*)(F.ws + WS_REST), LDR, 6};
            _Pragma("nounroll") for (int rp = 0; rp < REPS(1); ++rp) { GEMMCALL0(F.lds, g, S, E); } SEAM(sb + 0);
        }
#ifndef DIS_PREP
        if (IN(sb + 1)) { _Pragma("nounroll") for (int rp = 0; rp < REPS(8); ++rp) { ph_prep(F, l, rp + 1 == REPS(8)); } SEAM(sb + 1); }
#endif
#ifndef DIS_ATTN
        if (IN(sb + 2)) { _Pragma("nounroll") for (int rp = 0; rp < REPS(2); ++rp) { ph_attn(F, l); } SEAM(sb + 2); }
#endif
#ifndef DIS_SCAN
        if (IN(sb + 3)) { _Pragma("nounroll") for (int rp = 0; rp < REPS(3); ++rp) { ph_prep3f(F, l); } SEAM(sb + 3); }
        if (IN(sb + 4)) {
            if (F.bid >= 64 && F.G > 64) { if (l == 0) ph_mods(F, 1, DEPTH, F.bid - 64, F.G - 64); ph_convert(F, l, 1, F.bid - 64, F.G - 64); ph_scan_warm(F, l); }
            else { if (F.G <= 64) { if (l == 0) ph_mods(F, 1, DEPTH, F.bid, F.G); ph_convert(F, l, 1, F.bid, F.G); __syncthreads(); }
                   _Pragma("nounroll") for (int rp = 0; rp < REPS(4); ++rp) { ph_seqscan(F, l); __syncthreads(); } }
            SEAM(sb + 4); }
#endif
#ifndef DIS_ROUT
        if (IN(sb + 5)) { _Pragma("nounroll") for (int rp = 0; rp < REPS(5); ++rp) { ph_rwkv_out(F, l); } SEAM(sb + 5); }
#endif
        if (IN(sb + 6)) {
            pg8::Gemm g{(const bf16_t*)(F.ws + WS_ACT), (const bf16_t*)(F.ws + WS_WOUT), D, 0}; pg8::SplitOrder S; S.init(D, 4, D / 64, l < DEPTH - 1, F.G, F.bid);
            _Pragma("nounroll") for (int rp = 0; rp < REPS(11); ++rp) { pg8::EpiDelta E{(bf16_t*)(F.ws + WS_R1), gates + 2 * D, (bf16_t*)(F.ws + WS_R1 + 68 * MiB)};
            GEMMCALL1(F.lds, g, S, E); } SEAM(sb + 6);
        }
#ifndef DIS_LN
        if (IN(sb + 7)) { _Pragma("nounroll") for (int rp = 0; rp < REPS(9); ++rp) { ph_ln<1>(F, l, rp + 1 < REPS(9)); } SEAM(sb + 7); }
#endif
        if (l & 1) {
#ifndef DIS_GATH
            if (IN(sb + 8)) { ph_moe_gather(F, l); SEAM(sb + 8); }
#endif
            if (IN(sb + 9)) {
                pg8::Gemm g{(const bf16_t*)(F.ws + WS_ACT), (const bf16_t*)(F.ws + WS_WFF), D, (size_t)2 * DFFE * D * 2}; pg8::MoeGatherOrder S; S.init(F.ctl + CW_CNT + 64 * (l >> 1), 2 * DFFE, F.G, F.bid); S.tok = (const int*)(F.ws + WS_TOK);
                pg8::EpiSwiGLU E{(bf16_t*)(F.ws + WS_R1), DFFE};
                _Pragma("nounroll") for (int rp = 0; rp < REPS(15); ++rp) { GEMMCALL2(F.lds, g, S, E); } SEAM(sb + 9);
            }
            if (IN(sb + 10)) {
                pg8::Gemm g{(const bf16_t*)(F.ws + WS_R1), (const bf16_t*)(F.ws + WS_WFF2), DFFE, (size_t)D * DFFE * 2}; pg8::MoeOrder S; S.init(F.ctl + CW_CNT + 64 * (l >> 1), D, F.G, F.bid);
                pg8::EpiBf16 E{(bf16_t*)(F.ws + WS_R2), D, nullptr, 0, 0};
                _Pragma("nounroll") for (int rp = 0; rp < REPS(7); ++rp) { GEMMCALL3(F.lds, g, S, E); } SEAM(sb + 10);
            }
        } else {
            if (IN(sb + 8)) { SEAM(sb + 8); }
            if (IN(sb + 9)) {
                pg8::Gemm g{(const bf16_t*)(F.ws + WS_ACT), (const bf16_t*)(F.ws + WS_WFF), D, 0}; pg8::StaticOrder S; S.init(mact, 2 * DFF, F.G, F.bid);
                pg8::EpiSwiGLU E{(bf16_t*)(F.ws + WS_R1), DFF};
                _Pragma("nounroll") for (int rp = 0; rp < REPS(6); ++rp) { GEMMCALL4(F.lds, g, S, E); } SEAM(sb + 9);
            }
            if (IN(sb + 10)) {
                pg8::Gemm g{(const bf16_t*)(F.ws + WS_R1), (const bf16_t*)(F.ws + WS_WFF2), DFF, 0}; pg8::SplitOrder S; S.init(D, 2, DFF / 64, l < DEPTH - 1, F.G, F.bid);
                _Pragma("nounroll") for (int rp = 0; rp < REPS(12); ++rp) { pg8::EpiDelta E{(bf16_t*)(F.ws + WS_R2), gates + 5 * D, (bf16_t*)(F.ws + WS_R2 + 68 * MiB)};
                GEMMCALL5(F.lds, g, S, E); } SEAM(sb + 10);
            }
        }
#ifndef DIS_LN
        if (IN(sb + 11)) { _Pragma("nounroll") for (int rp = 0; rp < REPS(9); ++rp) { ph_ln<2>(F, l, rp + 1 < REPS(9)); } _Pragma("nounroll") for (int rp = 0; rp < REPS(10); ++rp) { if (l + 1 < DEPTH) ph_convert(F, l + 1, 0, F.bid, F.G); } SEAM(sb + 11); }
#endif
    }
}

#ifndef MK_PER_STEP
#define MK_PER_STEP 0
#endif
extern "C" void kernel_launch(void* const* d_in, const int* in_sizes, int n_in, void* d_out, int out_size, void* d_ws, size_t ws_size, hipStream_t stream) {
    static int grid = 0;
    if (grid == 0) {
        if (n_in != 37 || out_size != BT * D || ws_size < WS_END) { fprintf(stderr, "kernel_launch: unexpected problem (n_in %d out %d ws %zu, need %zu)\n", n_in, out_size, ws_size, (size_t)WS_END); grid = -1; return; }
        int dev = 0, cus = 0, per_cu = 0;
        if (hipGetDevice(&dev) != hipSuccess || hipDeviceGetAttribute(&cus, hipDeviceAttributeMultiprocessorCount, dev) != hipSuccess) { grid = -1; return; }
        if (hipFuncSetAttribute((const void*)fwd_kernel, hipFuncAttributeMaxDynamicSharedMemorySize, LDS_BYTES) != hipSuccess) { fprintf(stderr, "kernel_launch: hipFuncSetAttribute failed\n"); grid = -1; return; }
        if (hipOccupancyMaxActiveBlocksPerMultiprocessor(&per_cu, (const void*)fwd_kernel, NTHR, LDS_BYTES) != hipSuccess || per_cu < 1) { fprintf(stderr, "kernel_launch: occupancy query says %d\n", per_cu); grid = -1; return; }
        grid = cus;
    }
    if (grid <= 0) return;
    hipMemsetAsync((char*)d_ws + WS_CTL, 0, CTL_ZERO_BYTES, stream);
    Args a{};
    for (int i = 0; i < 37; ++i) a.in[i] = (const float*)d_in[i];
    a.out = (float*)d_out; a.ws = (unsigned char*)d_ws;
#if MK_PER_STEP
    for (int s = 0; s < NSTEP; ++s) { a.s_lo = s; a.s_hi = s + 1; hipLaunchKernelGGL(fwd_kernel, dim3(grid), dim3(NTHR), LDS_BYTES, stream, a); }
#else
    a.s_lo = 0; a.s_hi = NSTEP; hipLaunchKernelGGL(fwd_kernel, dim3(grid), dim3(NTHR), LDS_BYTES, stream, a);
#endif
}
```
